# Optimizing an MI355X kernel written in HIP

```python
import jax, jax.numpy as jnp
from jax import lax
import numpy as np

D_MODEL = 1024
BATCH = 16
SEQ = 256
DEPTH = 2
DEC_BATCH = 4
DEC_SEQ = 2048
PAST_LEN = 256

GRID_W = 64
N_EVEN = (DEPTH + 1) // 2
N_ODD = DEPTH // 2
HEAD_DIM = 64
N_HEADS = 8
N_KV_HEADS = 2
GROUP = N_HEADS // N_KV_HEADS
ATT_WIDTH = N_HEADS * HEAD_DIM
KV_WIDTH = N_KV_HEADS * HEAD_DIM
WINDOW = 128
BLK = 128
ROPE_BASE = 10000.0
CONV_CH = 512
CONV_K = 31
IN_EVEN = ATT_WIDTH + 2 * KV_WIDTH + 2 * CONV_CH
MIX_EVEN = ATT_WIDTH + CONV_CH
LRU_WIDTH = 1024
LRU_BLOCKS = 8
LRU_BW = LRU_WIDTH // LRU_BLOCKS
LRU_CONV_K = 4
LRU_C = 8.0
D_FF = 4 * D_MODEL
EPS = 1e-6
NEG_INF = -1e30

kernel_name = "hybrid_dit_swa_conformer_rglru_step"


def _rmsnorm(x, g):
    xf = x.astype(jnp.float32)
    y = xf * lax.rsqrt(jnp.mean(xf * xf, axis=-1, keepdims=True) + EPS)
    return (y * g.astype(jnp.float32)).astype(x.dtype)


def _layernorm(x, g, b):
    xf = x.astype(jnp.float32)
    mu = jnp.mean(xf, axis=-1, keepdims=True)
    var = jnp.mean(jnp.square(xf - mu), axis=-1, keepdims=True)
    y = (xf - mu) * lax.rsqrt(var + EPS)
    return (y * g.astype(jnp.float32) + b.astype(jnp.float32)).astype(x.dtype)


def _adaln(cond, w_mod, b_mod):
    return jnp.split(jax.nn.silu(cond) @ w_mod + b_mod, 6, axis=-1)


def _modulate(x, g, shift, scale):
    return _rmsnorm(x, g) * (1 + scale) + shift


def _sq_relu_mlp(h, w1, w2):
    return jnp.square(jax.nn.relu(h @ w1)) @ w2


def _dwconv(x, w, b, pad_l, pad_r):
    y = lax.conv_general_dilated(
        x, w[:, None, :].astype(x.dtype), window_strides=(1,),
        padding=[(pad_l, pad_r)], dimension_numbers=('NWC', 'WIO', 'NWC'),
        feature_group_count=x.shape[-1])
    return y + b


def _rope_axis(x, pos):
    n = x.shape[-1] // 2
    inv = ROPE_BASE ** (-jnp.arange(n, dtype=jnp.float32) / n)
    ang = pos.astype(jnp.float32)[:, None] * inv[None, :]
    cos = jnp.cos(ang)[:, None, :]
    sin = jnp.sin(ang)[:, None, :]
    x1, x2 = x[..., :n], x[..., n:]
    return jnp.concatenate([x1 * cos - x2 * sin, x2 * cos + x1 * sin], axis=-1)


def _axial_rope(x):
    T = x.shape[1]
    rows = T // GRID_W
    row = jnp.repeat(jnp.arange(rows), GRID_W)
    col = jnp.tile(jnp.arange(GRID_W), rows)
    xf = x.astype(jnp.float32)
    h = HEAD_DIM // 2
    out = jnp.concatenate([_rope_axis(xf[..., :h], row), _rope_axis(xf[..., h:], col)], axis=-1)
    return out.astype(x.dtype)


def _attend(q, k, v, mask, sink):
    B, Q = q.shape[0], q.shape[1]
    s = jnp.einsum('bqkgd,bskd->bkgqs', q, k).astype(jnp.float32) * (HEAD_DIM ** -0.5)
    if mask is not None:
        s = jnp.where(mask, s, NEG_INF)
    sink_col = jnp.broadcast_to(sink.astype(jnp.float32)[None, :, :, None, None],
                                (B, N_KV_HEADS, GROUP, Q, 1))
    p = jax.nn.softmax(jnp.concatenate([s, sink_col], axis=-1), axis=-1)[..., :-1]
    return jnp.einsum('bkgqs,bskd->bqkgd', p.astype(v.dtype), v)


def _context_attention(q, k, v, sink):
    B, C = q.shape[0], q.shape[1]
    nq = C // BLK
    qb = q.reshape(B, nq, BLK, N_KV_HEADS, GROUP, HEAD_DIM).transpose(1, 0, 2, 3, 4, 5)
    o = lax.map(lambda qi: _attend(qi, k, v, None, sink), qb)
    return o.transpose(1, 0, 2, 3, 4, 5).reshape(B, C, ATT_WIDTH)


def _latent_attention(q, k, v, ck, cv, sink):
    B, T = q.shape[0], q.shape[1]
    nb = T // BLK
    C = ck.shape[1]
    qb = q.reshape(B, nb, BLK, N_KV_HEADS, GROUP, HEAD_DIM).transpose(1, 0, 2, 3, 4, 5)
    kp = jnp.pad(k, ((0, 0), (BLK, BLK), (0, 0), (0, 0)))
    vp = jnp.pad(v, ((0, 0), (BLK, BLK), (0, 0), (0, 0)))
    a_idx = jnp.arange(BLK)[:, None]
    b_idx = jnp.arange(3 * BLK)[None, :]
    ctx_mask = jnp.ones((BLK, C), dtype=bool)

    def block(args):
        n, qi = args
        kw = lax.dynamic_slice_in_dim(kp, n * BLK, 3 * BLK, axis=1)
        vw = lax.dynamic_slice_in_dim(vp, n * BLK, 3 * BLK, axis=1)
        i = n * BLK + a_idx
        j = n * BLK - BLK + b_idx
        m = (jnp.abs(i - j) <= WINDOW) & (j >= 0) & (j < T)
        return _attend(qi, jnp.concatenate([kw, ck], axis=1), jnp.concatenate([vw, cv], axis=1),
                       jnp.concatenate([m, ctx_mask], axis=1), sink)

    o = lax.map(block, (jnp.arange(nb), qb))
    return o.transpose(1, 0, 2, 3, 4, 5).reshape(B, T, ATT_WIDTH)


def _conformer_conv(u, w, b, g, beta):
    a, gate = jnp.split(u, 2, axis=-1)
    z = _dwconv(a * jax.nn.sigmoid(gate), w, b, CONV_K // 2, CONV_K // 2)
    return jax.nn.silu(_layernorm(z, g, beta))


def _even_split(h, w_in):
    B, T = h.shape[0], h.shape[1]
    q, k, v, u = jnp.split(h @ w_in, [ATT_WIDTH, ATT_WIDTH + KV_WIDTH, ATT_WIDTH + 2 * KV_WIDTH], axis=-1)
    return (q.reshape(B, T, N_HEADS, HEAD_DIM), k.reshape(B, T, N_KV_HEADS, HEAD_DIM),
            v.reshape(B, T, N_KV_HEADS, HEAD_DIM), u)


def _even_ctx(h, w_in, w_out, sink, cw, cb, cg, cbeta):
    q, k, v, u = _even_split(h, w_in)
    o_att = _context_attention(q, k, v, sink.reshape(N_KV_HEADS, GROUP))
    o_conv = _conformer_conv(u, cw, cb, cg, cbeta)
    return jnp.concatenate([o_att, o_conv], axis=-1) @ w_out, k, v


def _even_lat(h, ck, cv, w_in, w_out, sink, cw, cb, cg, cbeta):
    q, k, v, u = _even_split(h, w_in)
    q = _axial_rope(q)
    k = _axial_rope(k)
    o_att = _latent_attention(q, k, v, ck, cv, sink.reshape(N_KV_HEADS, GROUP))
    o_conv = _conformer_conv(u, cw, cb, cg, cbeta)
    return jnp.concatenate([o_att, o_conv], axis=-1) @ w_out


def _lru_coeffs(xc, wa, ba, wx, bx, lam):
    B, T = xc.shape[0], xc.shape[1]
    xb = xc.reshape(B, T, LRU_BLOCKS, LRU_BW)
    r = jax.nn.sigmoid(jnp.einsum('btnc,ncd->btnd', xb, wa.astype(jnp.float32)).reshape(B, T, LRU_WIDTH)
                       + ba.astype(jnp.float32))
    i = jax.nn.sigmoid(jnp.einsum('btnc,ncd->btnd', xb, wx.astype(jnp.float32)).reshape(B, T, LRU_WIDTH)
                       + bx.astype(jnp.float32))
    log_a = -LRU_C * r * jax.nn.softplus(-lam.astype(jnp.float32))
    a = jnp.exp(log_a)
    return a, jnp.sqrt(-jnp.expm1(2.0 * log_a)) * (i * xc)


def _linear_scan(a, b, h0, reverse):
    idx = -1 if reverse else 0
    b = b.at[:, idx].add(a[:, idx] * h0)

    def comb(l, r):
        al, bl = l
        ar, br = r
        return al * ar, ar * bl + br

    _, h = lax.associative_scan(comb, (a, b), reverse=reverse, axis=1)
    return h


def _odd_core(h, h0, w_in, w_out, cw, cb, wa, ba, wx, bx, lam):
    gate_br, rec = jnp.split(h @ w_in, 2, axis=-1)
    xc = _dwconv(rec, cw, cb, 1, 2).astype(jnp.float32)
    a_f, b_f = _lru_coeffs(xc, wa[0], ba[0], wx[0], bx[0], lam[0])
    h_f = _linear_scan(a_f, b_f, h0[:, 0].astype(jnp.float32), False)
    a_b, b_b = _lru_coeffs(xc, wa[1], ba[1], wx[1], bx[1], lam[1])
    h_b = _linear_scan(a_b, b_b, h0[:, 1].astype(jnp.float32), True)
    y = (h_f + h_b).astype(h.dtype) * jax.nn.gelu(gate_br)
    return y @ w_out, h_f, h_b


def setup_inputs(seed: int = 0) -> dict:
    key = jax.random.key(seed)
    ks = jax.random.split(key, 32)

    def nrm(k, shape, scale):
        return jax.random.normal(k, shape, jnp.float32) * scale

    u = jax.random.uniform(ks[28], (N_ODD, 2, LRU_WIDTH), jnp.float32, minval=0.9, maxval=0.999)
    a_init = u ** (1.0 / LRU_C)
    return {
        "x_prompt": nrm(ks[0], (BATCH, SEQ, D_MODEL), 1.0),
        "x_sample": nrm(ks[1], (DEC_BATCH, DEC_SEQ, D_MODEL), 1.0),
        "c": nrm(ks[2], (DEC_BATCH, D_MODEL), 1.0),
        "cache_k": nrm(ks[3], (DEC_BATCH, N_EVEN, PAST_LEN, N_KV_HEADS, HEAD_DIM), 1.0),
        "cache_v": nrm(ks[4], (DEC_BATCH, N_EVEN, PAST_LEN, N_KV_HEADS, HEAD_DIM), 1.0),
        "state_lru": nrm(ks[5], (DEC_BATCH, N_ODD, 2, LRU_WIDTH), 0.5),
        "c_ctx": nrm(ks[6], (D_MODEL,), 1.0),
        "w_mod": nrm(ks[7], (DEPTH, D_MODEL, 6 * D_MODEL), D_MODEL ** -0.5),
        "b_mod": nrm(ks[8], (DEPTH, 6 * D_MODEL), 0.02),
        "norm_mix": 1.0 + nrm(ks[9], (DEPTH, D_MODEL), 0.1),
        "norm_ffn": 1.0 + nrm(ks[10], (DEPTH, D_MODEL), 0.1),
        "w_ff1": nrm(ks[11], (DEPTH, D_MODEL, D_FF), D_MODEL ** -0.5),
        "w_ff2": nrm(ks[12], (DEPTH, D_FF, D_MODEL), D_FF ** -0.5),
        "att_in": nrm(ks[13], (N_EVEN, D_MODEL, IN_EVEN), D_MODEL ** -0.5),
        "att_out": nrm(ks[14], (N_EVEN, MIX_EVEN, D_MODEL), MIX_EVEN ** -0.5),
        "att_sink": nrm(ks[15], (N_EVEN, N_HEADS), 0.5),
        "conv_w": nrm(ks[16], (N_EVEN, CONV_K, CONV_CH), CONV_K ** -0.5),
        "conv_b": nrm(ks[17], (N_EVEN, CONV_CH), 0.02),
        "conv_norm_g": 1.0 + nrm(ks[18], (N_EVEN, CONV_CH), 0.1),
        "conv_norm_b": nrm(ks[19], (N_EVEN, CONV_CH), 0.02),
        "lru_in": nrm(ks[20], (N_ODD, D_MODEL, 2 * LRU_WIDTH), D_MODEL ** -0.5),
        "lru_out": nrm(ks[21], (N_ODD, LRU_WIDTH, D_MODEL), LRU_WIDTH ** -0.5),
        "lru_conv_w": nrm(ks[22], (N_ODD, LRU_CONV_K, LRU_WIDTH), LRU_CONV_K ** -0.5),
        "lru_conv_b": nrm(ks[23], (N_ODD, LRU_WIDTH), 0.02),
        "lru_wa": nrm(ks[24], (N_ODD, 2, LRU_BLOCKS, LRU_BW, LRU_BW), LRU_BW ** -0.5),
        "lru_ba": nrm(ks[25], (N_ODD, 2, LRU_WIDTH), 0.02),
        "lru_wx": nrm(ks[26], (N_ODD, 2, LRU_BLOCKS, LRU_BW, LRU_BW), LRU_BW ** -0.5),
        "lru_bx": nrm(ks[27], (N_ODD, 2, LRU_WIDTH), 0.02),
        "lru_lam": jnp.log(a_init) - jnp.log1p(-a_init),
        "final_norm": 1.0 + nrm(ks[29], (D_MODEL,), 0.1),
    }


def reference(x_prompt, x_sample, c, cache_k, cache_v, state_lru, c_ctx,
              w_mod, b_mod, norm_mix, norm_ffn, w_ff1, w_ff2,
              att_in, att_out, att_sink, conv_w, conv_b, conv_norm_g, conv_norm_b,
              lru_in, lru_out, lru_conv_w, lru_conv_b, lru_wa, lru_ba, lru_wx, lru_bx, lru_lam,
              final_norm):
    y_p = x_prompt
    y_s = x_sample
    cond_ctx = c_ctx[None, None, :]
    cond_lat = c[:, None, :]
    new_k, new_v, new_h = [], [], []
    for li in range(DEPTH):
        mp = _adaln(cond_ctx, w_mod[li], b_mod[li])
        ms = _adaln(cond_lat, w_mod[li], b_mod[li])
        hp = _modulate(y_p, norm_mix[li], mp[0], mp[1])
        hs = _modulate(y_s, norm_mix[li], ms[0], ms[1])
        if li % 2 == 0:
            e = li // 2
            ep = (att_in[e], att_out[e], att_sink[e], conv_w[e], conv_b[e], conv_norm_g[e], conv_norm_b[e])
            op, kp, vp = _even_ctx(hp, *ep)
            new_k.append(kp)
            new_v.append(vp)
            os_ = _even_lat(hs, cache_k[:, e], cache_v[:, e], *ep)
        else:
            o = li // 2
            opar = (lru_in[o], lru_out[o], lru_conv_w[o], lru_conv_b[o],
                    lru_wa[o], lru_ba[o], lru_wx[o], lru_bx[o], lru_lam[o])
            h0 = jnp.zeros((y_p.shape[0], 2, LRU_WIDTH), jnp.float32)
            op, hf_ctx, hb_ctx = _odd_core(hp, h0, *opar)
            new_h.append(jnp.stack([hf_ctx[:, -1], hb_ctx[:, 0]], axis=1).astype(y_p.dtype))
            os_, _, _ = _odd_core(hs, state_lru[:, o], *opar)
        y_p = y_p + mp[2] * op
        y_s = y_s + ms[2] * os_
        y_p = y_p + mp[5] * _sq_relu_mlp(_modulate(y_p, norm_ffn[li], mp[3], mp[4]), w_ff1[li], w_ff2[li])
        y_s = y_s + ms[5] * _sq_relu_mlp(_modulate(y_s, norm_ffn[li], ms[3], ms[4]), w_ff1[li], w_ff2[li])
    y_prompt = _rmsnorm(y_p, final_norm)
    y_sample = _rmsnorm(y_s, final_norm)
    new_cache_k = jnp.stack(new_k, axis=1)
    new_cache_v = jnp.stack(new_v, axis=1)
    new_state_lru = jnp.stack(new_h, axis=1)
    return (y_prompt, y_sample, new_cache_k, new_cache_v, new_state_lru)
```

```cpp
#include <hip/hip_runtime.h>
#include <hip/hip_cooperative_groups.h>
#include <cstdio>
#include <cstdint>
namespace cg = cooperative_groups;

#ifndef N_LAUNCH_MODE
#define N_LAUNCH_MODE 1
#endif

#define LAS __attribute__((address_space(3)))
typedef unsigned short bf16_t;
typedef short bf16x8 __attribute__((ext_vector_type(8)));
typedef float f32x4 __attribute__((ext_vector_type(4)));
typedef float f32x2 __attribute__((ext_vector_type(2)));
typedef unsigned u32x4 __attribute__((ext_vector_type(4)));
typedef unsigned u32x2 __attribute__((ext_vector_type(2)));

constexpr int MT = 12288, MCTX = 4096, DM = 1024;
constexpr int NPH = 19;
constexpr size_t MiB = 1024 * 1024;
constexpr size_t WS_MOD = 0;
constexpr size_t WS_SUM = 256 * 1024;
constexpr size_t WS_CK = WS_SUM + 3 * MiB;
constexpr size_t WS_CVT = WS_CK + 256 * 1024;
constexpr size_t WS_WATTIN = 4 * MiB;
constexpr size_t WS_WATTOUT = WS_WATTIN + 3584 * 1024;
constexpr size_t WS_WFF1 = WS_WATTOUT + 2 * MiB;
constexpr size_t WS_WFF2 = WS_WFF1 + 16 * MiB;
constexpr size_t WS_WLRUIN = WS_WFF2 + 16 * MiB;
constexpr size_t WS_WLRUOUT = WS_WLRUIN + 4 * MiB;
constexpr size_t WS_WG = WS_WLRUOUT + 2 * MiB;
constexpr size_t WS_HA = 49 * MiB;
constexpr size_t WS_G = 73 * MiB;
constexpr size_t WS_R = 97 * MiB;
constexpr size_t WS_F = 121 * MiB;
constexpr size_t WS_END = 217 * MiB;
constexpr size_t WS_Q = WS_F;
constexpr size_t WS_KB = WS_F + 12 * MiB;
constexpr size_t WS_VTL = WS_F + 15 * MiB;
constexpr size_t WS_VTC = WS_F + 17 * MiB;
constexpr size_t WS_U = WS_F + 18 * MiB;
constexpr size_t WS_MIX = WS_F + 30 * MiB;
constexpr size_t WS_LB = WS_F;
static_assert(WS_WG + 1 * MiB <= WS_HA, "weights overflow");

constexpr int LDS_BYTES = 131072;

struct Params {
    const float* in[30];
    float* out;
    unsigned char* ws;
    int ph_lo, ph_hi;
};

__device__ __forceinline__ unsigned cvt_pk_bf16(float lo, float hi) { unsigned r; asm volatile("v_cvt_pk_bf16_f32 %0, %1, %2" : "=v"(r) : "v"(lo), "v"(hi)); return r; }
__device__ __forceinline__ float bflo(unsigned w) { return __uint_as_float(w << 16); }
__device__ __forceinline__ float bfhi(unsigned w) { return __uint_as_float(w & 0xffff0000u); }
__device__ __forceinline__ float sigmoidf_(float x) { return 1.0f / (1.0f + __expf(-x)); }

namespace pg8 {
constexpr int BM = 256, BK = 64, HALF = 128, HTB = HALF * BK * 2, STAGE_BYTES = 8 * HTB, NXCD = 8, WGM = 8;
__host__ __device__ __forceinline__ int lds_byte(int r, int c) { const int st = (r >> 4) * 2 + (c >> 5), rr = r & 15, cc = c & 31, ob = rr * 64 + cc * 2; return st * 1024 + (ob ^ (((ob >> 9) & 1) << 5)); }
__host__ __device__ __forceinline__ void stage_rc(int b, int& R, int& C) { const int st = b / 1024, sb = b % 1024, swz = sb ^ (((sb >> 9) & 1) << 5); R = (st >> 1) * 16 + swz / 64; C = (st & 1) * 32 + (swz % 64) / 2; }
__host__ __device__ __forceinline__ int perm32(int rho) { const int n = rho >> 4, i = rho & 15; return 8 * (i >> 2) + 4 * n + (i & 3); }

struct Unit { int pm, pn; };
struct Gemm { const bf16_t* A; const bf16_t* Bt; int M, N, K, lda, ldb, gshift, goff; };

struct StaticOrder {
    int nM, nN, nwg, G, c;
    __host__ __device__ void init(int M, int N, int G_, int c_) { nM = M / BM; nN = N / BM; nwg = nM * nN; G = G_; c = c_; }
    __host__ __device__ bool next(int i, Unit& u) const {
        const long L = (long)i * G + c; if (L >= nwg) return false;
        int wgid = (int)L; { const int q = nwg / NXCD, r = nwg % NXCD, xcd = wgid % NXCD, off = wgid / NXCD; wgid = (xcd < r ? xcd * (q + 1) : r * (q + 1) + (xcd - r) * q) + off; }
        const int nig = WGM * nN, gid = wgid / nig, fm = gid * WGM, gsz = (nM - fm) < WGM ? (nM - fm) : WGM;
        u.pm = fm + ((wgid % nig) % gsz); u.pn = (wgid % nig) / gsz; return true;
    }
};

template <class Epi>
__device__ __forceinline__ void gemm_phase(LAS unsigned char* lds, const Gemm g, const StaticOrder& S, const Epi& E) {
    const int tid = threadIdx.x, wid = __builtin_amdgcn_readfirstlane(tid >> 6), lane = tid & 63, wr = wid >> 2, wc = wid & 3, fr = lane & 15, fq = lane >> 4;
    const int K = g.K, nt = K / BK;
    unsigned voffA[2], voffB[2];
#pragma unroll
    for (int i = 0; i < 2; ++i) { int R, C; stage_rc(tid * 16 + i * 8192, R, C); const int Rb = Epi::PERM ? ((R & ~31) + perm32(R & 31)) : R;
        voffA[i] = (unsigned)(R * g.lda + C) * 2u; voffB[i] = (unsigned)(Rb * g.ldb + C) * 2u; }
    const size_t kstep = (size_t)(BK * 2);
    const size_t hstepA = (size_t)HALF * g.lda * 2, hstepB = (size_t)HALF * g.ldb * 2;
    const size_t tstepA = 2 * hstepA, tstepB = 2 * hstepB;
    const unsigned ldsw = (unsigned)wid * 1024u;
    const int aoff = lds_byte(wr * 64 + fr, fq * 8), boff = lds_byte(wc * 32 + fr, fq * 8);
#define PG8_SA(b, h) (((b) * 2 + (h)) * HTB)
#define PG8_SB(b, h) ((4 + (b) * 2 + (h)) * HTB)
#define PG8_STAGE(bufoff, gbase, voff) do { _Pragma("unroll") for (int _i = 0; _i < 2; ++_i) \
        __builtin_amdgcn_global_load_lds((const unsigned*)((const char*)(gbase) + (voff)[_i]), (LAS unsigned*)(lds + (bufoff) + ldsw + _i * 8192), 16, 0, 0); } while (0)
#define PG8_LDA(dst, b, h) do { _Pragma("unroll") for (int m = 0; m < 4; ++m) _Pragma("unroll") for (int k = 0; k < 2; ++k) dst[m][k] = *(const LAS bf16x8*)(lds + PG8_SA(b, h) + aoff + m * 2048 + k * 1024); } while (0)
#define PG8_LDB(dst, b, h) do { _Pragma("unroll") for (int n = 0; n < 2; ++n) _Pragma("unroll") for (int k = 0; k < 2; ++k) dst[n][k] = *(const LAS bf16x8*)(lds + PG8_SB(b, h) + boff + n * 2048 + k * 1024); } while (0)
#define PG8_MMA(ai, bj, At, Bt) do { __builtin_amdgcn_s_setprio(1); _Pragma("unroll") for (int m = 0; m < 4; ++m) _Pragma("unroll") for (int n = 0; n < 2; ++n) _Pragma("unroll") for (int k = 0; k < 2; ++k) \
        acc[ai][bj][m][n] = __builtin_amdgcn_mfma_f32_16x16x32_bf16(Bt[n][k], At[m][k], acc[ai][bj][m][n], 0, 0, 0); __builtin_amdgcn_s_setprio(0); } while (0)
#define PG8_WAIT_V(n) asm volatile("s_waitcnt vmcnt(" #n ")" ::: "memory")
#define PG8_WAIT_L(n) asm volatile("s_waitcnt lgkmcnt(" #n ")" ::: "memory")
#define PG8_BAR __builtin_amdgcn_s_barrier()
#define PG8_SCHED __builtin_amdgcn_sched_barrier(0)
    Unit cur, nxt; int ui = 0;
    if (!S.next(0, cur)) return;
    f32x4 acc[2][2][4][2];
#pragma unroll
    for (int a = 0; a < 2; ++a)
#pragma unroll
        for (int b = 0; b < 2; ++b)
#pragma unroll
            for (int m = 0; m < 4; ++m)
#pragma unroll
                for (int n = 0; n < 2; ++n) acc[a][b][m][n] = (f32x4){0.f, 0.f, 0.f, 0.f};
    bf16x8 At[4][2], B0[2][2], B1[2][2];
    const char* cA = (const char*)g.A + (size_t)cur.pm * tstepA + (size_t)(cur.pn >> g.gshift) * g.goff; const char* cB = (const char*)g.Bt + (size_t)cur.pn * tstepB;
    PG8_STAGE(PG8_SB(0, 0), cB, voffB); PG8_STAGE(PG8_SB(0, 1), cB + hstepB, voffB); PG8_STAGE(PG8_SA(0, 0), cA, voffA); PG8_STAGE(PG8_SA(0, 1), cA + hstepA, voffA);
    if (wr == 1) PG8_BAR;
    PG8_WAIT_V(2); PG8_BAR;
    PG8_STAGE(PG8_SB(1, 0), cB + kstep, voffB); PG8_STAGE(PG8_SA(1, 0), cA + kstep, voffA); PG8_STAGE(PG8_SB(1, 1), cB + hstepB + kstep, voffB);
    PG8_WAIT_V(6); PG8_BAR;
    for (;;) {
        const bool has_next = S.next(ui + 1, nxt);
        const char* nA = has_next ? (const char*)g.A + (size_t)nxt.pm * tstepA + (size_t)(nxt.pn >> g.gshift) * g.goff : cA; const char* nB = has_next ? (const char*)g.Bt + (size_t)nxt.pn * tstepB : cB;
        for (int t = 0; t < nt; t += 2) {
            const bool last = (t == nt - 2);
            const char* a1 = cA + (size_t)(t + 1) * kstep;
            const char* a2 = last ? nA : cA + (size_t)(t + 2) * kstep; const char* b2 = last ? nB : cB + (size_t)(t + 2) * kstep;
            const char* a3 = a2 + kstep; const char* b3 = b2 + kstep;
            PG8_LDB(B0, 0, 0); PG8_LDB(B1, 0, 1); PG8_SCHED; PG8_LDA(At, 0, 0); PG8_STAGE(PG8_SA(1, 1), a1 + hstepA, voffA);
            PG8_WAIT_V(8); PG8_WAIT_L(0); PG8_BAR; PG8_MMA(0, 0, At, B0); PG8_MMA(0, 1, At, B1); PG8_BAR; PG8_SCHED;
            PG8_LDA(At, 0, 1); PG8_STAGE(PG8_SB(0, 0), b2, voffB); PG8_STAGE(PG8_SB(0, 1), b2 + hstepB, voffB); PG8_STAGE(PG8_SA(0, 0), a2, voffA);
            PG8_WAIT_V(8); PG8_WAIT_L(0); PG8_BAR; PG8_MMA(1, 0, At, B0); PG8_MMA(1, 1, At, B1); PG8_BAR; PG8_SCHED;
            PG8_LDB(B0, 1, 0); PG8_LDB(B1, 1, 1); PG8_SCHED; PG8_LDA(At, 1, 0); PG8_STAGE(PG8_SA(0, 1), a2 + hstepA, voffA);
            PG8_WAIT_V(8); PG8_WAIT_L(0); PG8_BAR; PG8_MMA(0, 0, At, B0); PG8_MMA(0, 1, At, B1); PG8_BAR; PG8_SCHED;
            PG8_LDA(At, 1, 1); PG8_STAGE(PG8_SB(1, 0), b3, voffB); PG8_STAGE(PG8_SB(1, 1), b3 + hstepB, voffB); PG8_STAGE(PG8_SA(1, 0), a3, voffA);
            PG8_WAIT_V(8); PG8_WAIT_L(0); PG8_BAR; PG8_MMA(1, 0, At, B0); PG8_MMA(1, 1, At, B1); PG8_BAR; PG8_SCHED;
        }
        if (wr == 0) PG8_BAR;
        E(acc, cur, wr, wc, fr, fq);
        if (!has_next) break;
#pragma unroll
        for (int a = 0; a < 2; ++a)
#pragma unroll
            for (int b = 0; b < 2; ++b)
#pragma unroll
                for (int m = 0; m < 4; ++m)
#pragma unroll
                    for (int n = 0; n < 2; ++n) acc[a][b][m][n] = (f32x4){0.f, 0.f, 0.f, 0.f};
        cur = nxt; cA = nA; cB = nB; ++ui;
        if (wr == 1) PG8_BAR;
    }
    PG8_WAIT_V(0);
    PG8_BAR;
#undef PG8_SA
#undef PG8_SB
#undef PG8_STAGE
#undef PG8_LDA
#undef PG8_LDB
#undef PG8_MMA
#undef PG8_WAIT_V
#undef PG8_WAIT_L
#undef PG8_BAR
#undef PG8_SCHED
}
}
using pg8::Unit;

struct EpiQKVU {
    static constexpr bool PERM = false;
    bf16_t *Q, *Kb, *VtL, *VtC, *U; float *outk, *outv;
    __device__ __forceinline__ void operator()(const f32x4 (&acc)[2][2][4][2], const Unit& u, int wr, int wc, int fr, int fq) const {
        const int pn = u.pn; const bool lat = u.pm >= 16;
        const int rbase = u.pm * 256 + wr * 64 + fr;
        if (pn < 3) {
            float inv[4];
#pragma unroll
            for (int j = 0; j < 4; ++j) inv[j] = exp2f(-(float)(4 * fq + j) * 0.8304820237218406f);
#pragma unroll
            for (int ai = 0; ai < 2; ++ai)
#pragma unroll
                for (int m = 0; m < 4; ++m) {
                    const int r = rbase + ai * 128 + m * 16;
                    float cs[4], sn[4];
                    int t = 0, b = 0;
                    if (lat) { t = (r - MCTX) & 2047; b = (r - MCTX) >> 11; const float pos = (float)((wc & 1) ? (t & 63) : (t >> 6));
#pragma unroll
                        for (int j = 0; j < 4; ++j) { const float ang = pos * inv[j]; sn[j] = __sinf(ang); cs[j] = __cosf(ang); } }
                    else { t = r & 255; b = r >> 8;
#pragma unroll
                        for (int j = 0; j < 4; ++j) { sn[j] = 0.f; cs[j] = 1.f; } }
#pragma unroll
                    for (int bj = 0; bj < 2; ++bj) {
                        const f32x4 x1 = acc[ai][bj][m][0], x2 = acc[ai][bj][m][1];
                        if (pn == 2 && bj == 1) {
#pragma unroll
                            for (int n = 0; n < 2; ++n) {
                                const f32x4 x = n ? x2 : x1;
                                const int c0 = wc * 32 + n * 16 + 4 * fq;
#pragma unroll
                                for (int j = 0; j < 4; ++j) { const int c = c0 + j, kvh = c >> 6, d = c & 63;
                                    const bf16_t hv = (bf16_t)(cvt_pk_bf16(x[j], 0.f) & 0xffffu);
                                    if (lat) VtL[((size_t)((b * 2 + kvh) * 64 + d)) * 2048 + t] = hv; else VtC[((size_t)((b * 2 + kvh) * 64 + d)) * 256 + t] = hv; }
                                if (!lat) *(f32x4*)(outv + (size_t)r * 128 + c0) = x;
                            }
                        } else {
                            f32x4 o1, o2;
#pragma unroll
                            for (int j = 0; j < 4; ++j) { o1[j] = x1[j] * cs[j] - x2[j] * sn[j]; o2[j] = x2[j] * cs[j] + x1[j] * sn[j]; }
                            if (pn < 2) {
                                bf16_t* dst = Q + (size_t)r * 512 + pn * 256 + bj * 128 + wc * 32 + 4 * fq;
                                u32x2 w1, w2; w1.x = cvt_pk_bf16(o1[0] * 0.125f, o1[1] * 0.125f); w1.y = cvt_pk_bf16(o1[2] * 0.125f, o1[3] * 0.125f);
                                w2.x = cvt_pk_bf16(o2[0] * 0.125f, o2[1] * 0.125f); w2.y = cvt_pk_bf16(o2[2] * 0.125f, o2[3] * 0.125f);
                                *(u32x2*)dst = w1; *(u32x2*)(dst + 16) = w2;
                            } else {
                                const int c0 = wc * 32 + 4 * fq;
                                bf16_t* dst = Kb + (size_t)r * 128 + c0;
                                u32x2 w1, w2; w1.x = cvt_pk_bf16(o1[0], o1[1]); w1.y = cvt_pk_bf16(o1[2], o1[3]); w2.x = cvt_pk_bf16(o2[0], o2[1]); w2.y = cvt_pk_bf16(o2[2], o2[3]);
                                *(u32x2*)dst = w1; *(u32x2*)(dst + 16) = w2;
                                if (!lat) { *(f32x4*)(outk + (size_t)r * 128 + c0) = o1; *(f32x4*)(outk + (size_t)r * 128 + c0 + 16) = o2; }
                            }
                        }
                    }
                }
        } else {
            const int chb = (pn - 3) * 128 + wc * 32 + 4 * fq;
#pragma unroll
            for (int ai = 0; ai < 2; ++ai)
#pragma unroll
                for (int m = 0; m < 4; ++m) {
                    const int r = rbase + ai * 128 + m * 16;
#pragma unroll
                    for (int n = 0; n < 2; ++n) {
                        const f32x4 a = acc[ai][0][m][n], gt = acc[ai][1][m][n];
                        u32x2 w; w.x = cvt_pk_bf16(a[0] * sigmoidf_(gt[0]), a[1] * sigmoidf_(gt[1])); w.y = cvt_pk_bf16(a[2] * sigmoidf_(gt[2]), a[3] * sigmoidf_(gt[3]));
                        *(u32x2*)(U + (size_t)r * 512 + chb + n * 16) = w;
                    }
                }
        }
    }
};

template <bool FROMX> struct EpiResid {
    static constexpr bool PERM = false;
    const float* xp; const float* xs; float* Y; const float* gate;
    __device__ __forceinline__ void operator()(const f32x4 (&acc)[2][2][4][2], const Unit& u, int wr, int wc, int fr, int fq) const {
        const int mi = u.pm < 16 ? 0 : 1 + ((u.pm - 16) >> 3);
        const float* gp = gate + mi * 6144;
        const int rbase = u.pm * 256 + wr * 64 + fr;
#pragma unroll
        for (int bj = 0; bj < 2; ++bj)
#pragma unroll
            for (int n = 0; n < 2; ++n) {
                const int col = u.pn * 256 + bj * 128 + wc * 32 + n * 16 + 4 * fq;
                const f32x4 g4 = *(const f32x4*)(gp + col);
#pragma unroll
                for (int ai = 0; ai < 2; ++ai)
#pragma unroll
                    for (int m = 0; m < 4; ++m) {
                        const int r = rbase + ai * 128 + m * 16;
                        const float* bp = FROMX ? (u.pm < 16 ? xp + (size_t)r * 1024 : xs + (size_t)(r - MCTX) * 1024) : Y + (size_t)r * 1024;
                        const f32x4 b4 = *(const f32x4*)(bp + col);
                        *(f32x4*)(Y + (size_t)r * 1024 + col) = b4 + g4 * acc[ai][bj][m][n];
                    }
            }
    }
};

struct EpiSqRelu {
    static constexpr bool PERM = true;
    bf16_t* F;
    __device__ __forceinline__ void operator()(const f32x4 (&acc)[2][2][4][2], const Unit& u, int wr, int wc, int fr, int fq) const {
        const int rbase = u.pm * 256 + wr * 64 + fr, col0 = u.pn * 256 + wc * 32 + 8 * fq;
#pragma unroll
        for (int ai = 0; ai < 2; ++ai)
#pragma unroll
            for (int m = 0; m < 4; ++m) { bf16_t* rowp = F + (size_t)(rbase + ai * 128 + m * 16) * 4096 + col0;
#pragma unroll
                for (int bj = 0; bj < 2; ++bj) { f32x4 v0 = acc[ai][bj][m][0], v1 = acc[ai][bj][m][1];
#pragma unroll
                    for (int j = 0; j < 4; ++j) { const float a = fmaxf(v0[j], 0.f), b = fmaxf(v1[j], 0.f); v0[j] = a * a; v1[j] = b * b; }
                    u32x4 w; w.x = cvt_pk_bf16(v0[0], v0[1]); w.y = cvt_pk_bf16(v0[2], v0[3]); w.z = cvt_pk_bf16(v1[0], v1[1]); w.w = cvt_pk_bf16(v1[2], v1[3]);
                    *(u32x4*)(rowp + bj * 128) = w; } }
    }
};

__device__ __forceinline__ float gelu_tanh(float x) { const float u2 = 1.5957691216057308f * (x + 0.044715f * x * x * x); return x / (1.0f + __expf(-u2)); }

struct EpiLruIn {
    static constexpr bool PERM = true;
    bf16_t *G, *R;
    __device__ __forceinline__ void operator()(const f32x4 (&acc)[2][2][4][2], const Unit& u, int wr, int wc, int fr, int fq) const {
        const bool isg = u.pn < 4;
        bf16_t* O = isg ? G : R;
        const int rbase = u.pm * 256 + wr * 64 + fr, col0 = (u.pn & 3) * 256 + wc * 32 + 8 * fq;
#pragma unroll
        for (int ai = 0; ai < 2; ++ai)
#pragma unroll
            for (int m = 0; m < 4; ++m) { bf16_t* rowp = O + (size_t)(rbase + ai * 128 + m * 16) * 1024 + col0;
#pragma unroll
                for (int bj = 0; bj < 2; ++bj) { f32x4 v0 = acc[ai][bj][m][0], v1 = acc[ai][bj][m][1];
                    if (isg) {
#pragma unroll
                        for (int j = 0; j < 4; ++j) { v0[j] = gelu_tanh(v0[j]); v1[j] = gelu_tanh(v1[j]); } }
                    u32x4 w; w.x = cvt_pk_bf16(v0[0], v0[1]); w.y = cvt_pk_bf16(v0[2], v0[3]); w.z = cvt_pk_bf16(v1[0], v1[1]); w.w = cvt_pk_bf16(v1[2], v1[3]);
                    *(u32x4*)(rowp + bj * 128) = w; } }
    }
};

struct EpiGates {
    static constexpr bool PERM = false;
    const bf16_t* XC; unsigned* LB; const float *ba, *bx, *lam;
    __device__ __forceinline__ void operator()(const f32x4 (&acc)[2][2][4][2], const Unit& u, int wr, int wc, int fr, int fq) const {
        const int dir = u.pn & 1, grp = u.pn >> 1;
        const int rbase = u.pm * 256 + wr * 64 + fr;
#pragma unroll
        for (int n = 0; n < 2; ++n) {
            const int chb = grp * 128 + wc * 32 + n * 16 + 4 * fq;
            const f32x4 ba4 = *(const f32x4*)(ba + dir * 1024 + chb), bx4 = *(const f32x4*)(bx + dir * 1024 + chb), lm4 = *(const f32x4*)(lam + dir * 1024 + chb);
            float lu[4];
#pragma unroll
            for (int j = 0; j < 4; ++j) { const float e = __expf(-lm4[j]); lu[j] = -8.0f * e * (1.0f - e * (0.5f - e * (0.33333333f - e * 0.25f))); }
#pragma unroll
            for (int ai = 0; ai < 2; ++ai)
#pragma unroll
                for (int m = 0; m < 4; ++m) {
                    const int r = rbase + ai * 128 + m * 16;
                    const u32x2 xw = *(const u32x2*)(XC + (size_t)r * 1024 + chb);
                    const float xc[4] = {bflo(xw.x), bfhi(xw.x), bflo(xw.y), bfhi(xw.y)};
                    const f32x4 pr = acc[ai][0][m][n] + ba4, pi = acc[ai][1][m][n] + bx4;
                    u32x4 w;
#pragma unroll
                    for (int j = 0; j < 4; ++j) { const float rr = sigmoidf_(pr[j]), ii = sigmoidf_(pi[j]); const float la = rr * lu[j];
                        const float a2 = __expf(2.0f * la); const float bb = sqrtf(fmaxf(1.0f - a2, 0.f)) * ii * xc[j]; w[j] = cvt_pk_bf16(la, bb); }
                    *(u32x4*)(LB + ((size_t)dir * MT + r) * 1024 + chb) = w;
                    asm volatile("" ::: "memory");
                }
        }
    }
};

struct TJob { const float* src; bf16_t* dst; int K, N, ldd, kind; };
constexpr int N_ADA = 192, N_TR = 5696, N_CACHE = 32;

__device__ __forceinline__ void phase_prep(const Params& p, LAS unsigned char* lds) {
    const int tid = threadIdx.x;
    unsigned char* ws = p.ws;
    for (int it = blockIdx.x; it < N_ADA + N_TR + N_CACHE; it += gridDim.x) {
        if (it < N_ADA) {
            const int l = it / 96, n0 = (it % 96) * 64;
            LAS float* sc = (LAS float*)lds;
            LAS float* red = (LAS float*)(lds + 20480);
            for (int i = tid; i < 5120; i += 512) { const int j = i >> 10, k = i & 1023; const float x = (j == 0) ? p.in[6][k] : p.in[2][(j - 1) * 1024 + k]; sc[i] = x / (1.0f + __expf(-x)); }
            __syncthreads();
            const int col = tid & 63, kg = tid >> 6;
            const float* w = p.in[7] + (size_t)l * 1024 * 6144 + (size_t)(kg * 128) * 6144 + n0 + col;
            float a0 = 0.f, a1 = 0.f, a2 = 0.f, a3 = 0.f, a4 = 0.f;
#pragma unroll 8
            for (int k = 0; k < 128; ++k) { const float wv = w[(size_t)k * 6144]; const int kk = kg * 128 + k;
                a0 += sc[kk] * wv; a1 += sc[1024 + kk] * wv; a2 += sc[2048 + kk] * wv; a3 += sc[3072 + kk] * wv; a4 += sc[4096 + kk] * wv; }
            red[(kg * 5 + 0) * 64 + col] = a0; red[(kg * 5 + 1) * 64 + col] = a1; red[(kg * 5 + 2) * 64 + col] = a2; red[(kg * 5 + 3) * 64 + col] = a3; red[(kg * 5 + 4) * 64 + col] = a4;
            __syncthreads();
            if (tid < 320) { const int j = tid >> 6; float s = 0.f;
#pragma unroll
                for (int g = 0; g < 8; ++g) s += red[(g * 5 + j) * 64 + col];
                ((float*)(ws + WS_MOD))[(l * 5 + j) * 6144 + n0 + col] = s + p.in[8][l * 6144 + n0 + col]; }
            __syncthreads();
        } else if (it < N_ADA + N_TR) {
            int t = it - N_ADA; TJob j;
            if (t < 448) { j = {p.in[13], (bf16_t*)(ws + WS_WATTIN), 1024, 1792, 1024, 1}; }
            else if ((t -= 448) < 256) { j = {p.in[14], (bf16_t*)(ws + WS_WATTOUT), 1024, 1024, 1024, 0}; }
            else if ((t -= 256) < 2048) { const int l = t >> 10; t &= 1023; j = {p.in[11] + (size_t)l * 1024 * 4096, (bf16_t*)(ws + WS_WFF1) + (size_t)l * 4096 * 1024, 1024, 4096, 1024, 0}; }
            else if ((t -= 2048) < 2048) { const int l = t >> 10; t &= 1023; j = {p.in[12] + (size_t)l * 4096 * 1024, (bf16_t*)(ws + WS_WFF2) + (size_t)l * 1024 * 4096, 4096, 1024, 4096, 0}; }
            else if ((t -= 2048) < 512) { j = {p.in[20], (bf16_t*)(ws + WS_WLRUIN), 1024, 2048, 1024, 0}; }
            else if ((t -= 512) < 256) { j = {p.in[21], (bf16_t*)(ws + WS_WLRUOUT), 1024, 1024, 1024, 0}; }
            else { t -= 256; const int mtx = t >> 2; t &= 3; const int which = mtx >> 4, dir = (mtx >> 3) & 1, blk = mtx & 7;
                j = {(which ? p.in[26] : p.in[24]) + (size_t)(dir * 8 + blk) * 16384, (bf16_t*)(ws + WS_WG) + (size_t)(blk * 512 + dir * 256 + which * 128) * 128, 128, 128, 128, 0}; }
            const int nn = j.N >> 6, k0 = (t / nn) * 64, n0 = (t % nn) * 64;
            LAS bf16_t* tile = (LAS bf16_t*)lds;
#pragma unroll
            for (int ps = 0; ps < 2; ++ps) { const int kk = (tid >> 4) + 32 * ps, n4 = tid & 15;
                const f32x4 v = *(const f32x4*)(j.src + (size_t)(k0 + kk) * j.N + n0 + 4 * n4);
#pragma unroll
                for (int e = 0; e < 4; ++e) tile[(4 * n4 + e) * 72 + kk] = (bf16_t)(cvt_pk_bf16(v[e], 0.f) & 0xffffu); }
            __syncthreads();
            { const int nl = tid >> 3, k8 = tid & 7; int n = n0 + nl;
              if (j.kind == 1 && n >= 768) { const int np = n - 768, sel = np >> 9, chn = np & 511; n = 768 + (chn >> 7) * 256 + sel * 128 + (chn & 127); }
              const u32x4 v = *(const LAS u32x4*)(lds + nl * 144 + k8 * 16);
              *(u32x4*)(j.dst + (size_t)n * j.ldd + k0 + 8 * k8) = v; }
            __syncthreads();
        } else {
            const int ci = it - N_ADA - N_TR;
            bf16_t* cK = (bf16_t*)(ws + WS_CK); bf16_t* cVt = (bf16_t*)(ws + WS_CVT);
            for (int e = tid; e < 4096; e += 512) { const int o = ci * 4096 + e;
                { const int d = o & 63, t = (o >> 6) & 255, kvh = (o >> 14) & 1, b = o >> 15; cK[o] = (bf16_t)(cvt_pk_bf16(p.in[3][((size_t)(b * 256 + t) * 2 + kvh) * 64 + d], 0.f) & 0xffffu); }
                { const int t = o & 255, d = (o >> 8) & 63, kvh = (o >> 14) & 1, b = o >> 15; cVt[o] = (bf16_t)(cvt_pk_bf16(p.in[4][((size_t)(b * 256 + t) * 2 + kvh) * 64 + d], 0.f) & 0xffffu); } }
        }
    }
}

template <int MODE>
__device__ __forceinline__ void phase_norm(const Params& p, const float* gvec, const float* modl, int ch_shift, int ch_scale) {
    const int lane = threadIdx.x & 63, wid = threadIdx.x >> 6;
    bf16_t* HA = (bf16_t*)(p.ws + WS_HA);
    for (int row = blockIdx.x * 8 + wid; row < MT; row += gridDim.x * 8) {
        const float* src = (MODE == 0) ? (row < MCTX ? p.in[0] + (size_t)row * 1024 : p.in[1] + (size_t)(row - MCTX) * 1024) : p.out + (size_t)row * 1024;
        f32x4 v[4]; float ss = 0.f;
#pragma unroll
        for (int i = 0; i < 4; ++i) { v[i] = *(const f32x4*)(src + i * 256 + lane * 4); ss += v[i][0] * v[i][0] + v[i][1] * v[i][1] + v[i][2] * v[i][2] + v[i][3] * v[i][3]; }
#pragma unroll
        for (int o = 32; o >= 1; o >>= 1) ss += __shfl_xor(ss, o);
        const float rstd = rsqrtf(ss * (1.0f / 1024.0f) + 1e-6f);
        const int mi = row < MCTX ? 0 : 1 + ((row - MCTX) >> 11);
#pragma unroll
        for (int i = 0; i < 4; ++i) { const int c = i * 256 + lane * 4; const f32x4 g4 = *(const f32x4*)(gvec + c);
            f32x4 o = v[i] * rstd * g4;
            if (MODE < 2) { const f32x4 sc = *(const f32x4*)(modl + mi * 6144 + ch_scale * 1024 + c), sh = *(const f32x4*)(modl + mi * 6144 + ch_shift * 1024 + c);
                o = o * (sc + 1.0f) + sh;
                u32x2 w; w.x = cvt_pk_bf16(o[0], o[1]); w.y = cvt_pk_bf16(o[2], o[3]); *(u32x2*)(HA + (size_t)row * 1024 + c) = w; }
            else *(f32x4*)(p.out + (size_t)row * 1024 + c) = o; }
    }
}

constexpr int SV_OFF = 128 * 144;
__device__ __forceinline__ void attn_item(const Params& p, LAS unsigned char* lds, int it) {
    const int tid = threadIdx.x, lane = tid & 63, wid = tid >> 6, fr = lane & 15, fq = lane >> 4;
    unsigned char* ws = p.ws;
    const bf16_t* Q = (const bf16_t*)(ws + WS_Q); const bf16_t* Kb = (const bf16_t*)(ws + WS_KB);
    const bf16_t* VtL = (const bf16_t*)(ws + WS_VTL); const bf16_t* VtC = (const bf16_t*)(ws + WS_VTC);
    const bf16_t* cK = (const bf16_t*)(ws + WS_CK); const bf16_t* cVt = (const bf16_t*)(ws + WS_CVT);
    bf16_t* MIX = (bf16_t*)(ws + WS_MIX);
    const bool lat = it < 128;
    int b, kvh, n = 0, row0;
    if (lat) { b = it >> 5; kvh = (it >> 4) & 1; n = it & 15; row0 = MCTX + b * 2048 + n * 128; }
    else { const int i2 = it - 128; b = i2 >> 2; kvh = (i2 >> 1) & 1; row0 = b * 256 + (i2 & 1) * 128; }
    const int g = wid >> 1, qoff = (wid & 1) * 64, h = kvh * 4 + g;
    bf16x8 qreg[4][2];
#pragma unroll
    for (int qs = 0; qs < 4; ++qs)
#pragma unroll
        for (int dh = 0; dh < 2; ++dh) qreg[qs][dh] = *(const bf16x8*)(Q + (size_t)(row0 + qoff + qs * 16 + fr) * 512 + h * 64 + dh * 32 + fq * 8);
    const float sink = p.in[15][h];
    float m_[4], l_[4]; f32x4 o[4][4];
#pragma unroll
    for (int qs = 0; qs < 4; ++qs) { m_[qs] = sink; l_[qs] = (fq == 0) ? 1.0f : 0.0f;
#pragma unroll
        for (int ds = 0; ds < 4; ++ds) o[qs][ds] = (f32x4){0.f, 0.f, 0.f, 0.f}; }
    const int nch = lat ? 5 : 2;
    for (int c = 0; c < nch; ++c) {
        const bf16_t* kp; const bf16_t* vp; int kpitch, vpitch, mtype = 0;
        if (lat) {
            if (c < 3) { const int cb = n - 1 + c; if (cb < 0 || cb > 15) continue;
                kp = Kb + (size_t)(MCTX + b * 2048 + cb * 128) * 128 + kvh * 64; kpitch = 128; vp = VtL + (size_t)((b * 2 + kvh) * 64) * 2048 + cb * 128; vpitch = 2048; mtype = (c == 0) ? 1 : (c == 2 ? 2 : 0); }
            else { const int cc = c - 3; kp = cK + (size_t)((b * 2 + kvh) * 256 + cc * 128) * 64; kpitch = 64; vp = cVt + (size_t)((b * 2 + kvh) * 64) * 256 + cc * 128; vpitch = 256; }
        } else { kp = Kb + (size_t)(b * 256 + c * 128) * 128 + kvh * 64; kpitch = 128; vp = VtC + (size_t)((b * 2 + kvh) * 64) * 256 + c * 128; vpitch = 256; }
        __syncthreads();
#pragma unroll
        for (int e = 0; e < 2; ++e) { const int pc = tid + e * 512; const int key = pc >> 3, d8 = pc & 7;
            const u32x4 v = *(const u32x4*)(kp + (size_t)key * kpitch + d8 * 8); *(LAS u32x4*)(lds + key * 144 + d8 * 16) = v; }
#pragma unroll
        for (int e = 0; e < 2; ++e) { const int pc = tid + e * 512; const int d = pc >> 4, k8 = pc & 15;
            const u32x4 v = *(const u32x4*)(vp + (size_t)d * vpitch + k8 * 8); *(LAS u32x4*)(lds + SV_OFF + d * 272 + k8 * 16) = v; }
        __syncthreads();
#pragma unroll 1
        for (int ks = 0; ks < 4; ++ks) {
            bf16x8 kreg[2][2], vreg[4];
#pragma unroll
            for (int kt = 0; kt < 2; ++kt)
#pragma unroll
                for (int dh = 0; dh < 2; ++dh) kreg[kt][dh] = *(const LAS bf16x8*)(lds + (ks * 32 + kt * 16 + fr) * 144 + (dh * 32 + fq * 8) * 2);
#pragma unroll
            for (int ds = 0; ds < 4; ++ds) { const u32x2 lo = *(const LAS u32x2*)(lds + SV_OFF + (ds * 16 + fr) * 272 + (ks * 32 + 4 * fq) * 2);
                const u32x2 hi = *(const LAS u32x2*)(lds + SV_OFF + (ds * 16 + fr) * 272 + (ks * 32 + 16 + 4 * fq) * 2);
                const u32x4 vv = {lo.x, lo.y, hi.x, hi.y}; vreg[ds] = __builtin_bit_cast(bf16x8, vv); }
#pragma unroll
            for (int qs = 0; qs < 4; ++qs) {
                f32x4 s0 = {0.f, 0.f, 0.f, 0.f}, s1 = {0.f, 0.f, 0.f, 0.f};
                s0 = __builtin_amdgcn_mfma_f32_16x16x32_bf16(kreg[0][0], qreg[qs][0], s0, 0, 0, 0); s0 = __builtin_amdgcn_mfma_f32_16x16x32_bf16(kreg[0][1], qreg[qs][1], s0, 0, 0, 0);
                s1 = __builtin_amdgcn_mfma_f32_16x16x32_bf16(kreg[1][0], qreg[qs][0], s1, 0, 0, 0); s1 = __builtin_amdgcn_mfma_f32_16x16x32_bf16(kreg[1][1], qreg[qs][1], s1, 0, 0, 0);
                if (mtype) { const int ii = qoff + qs * 16 + fr;
#pragma unroll
                    for (int j = 0; j < 4; ++j) { const int j0 = ks * 32 + 4 * fq + j, j1 = j0 + 16;
                        const bool v0 = (mtype == 1) ? (j0 >= ii) : (j0 <= ii), v1 = (mtype == 1) ? (j1 >= ii) : (j1 <= ii);
                        if (!v0) s0[j] = -1e30f; if (!v1) s1[j] = -1e30f; } }
                float mx = fmaxf(fmaxf(fmaxf(s0[0], s0[1]), fmaxf(s0[2], s0[3])), fmaxf(fmaxf(s1[0], s1[1]), fmaxf(s1[2], s1[3])));
                mx = fmaxf(mx, __shfl_xor(mx, 16)); mx = fmaxf(mx, __shfl_xor(mx, 32));
                const float mn = fmaxf(m_[qs], mx), alpha = __expf(m_[qs] - mn); m_[qs] = mn;
                float ps = 0.f;
#pragma unroll
                for (int j = 0; j < 4; ++j) { s0[j] = __expf(s0[j] - mn); s1[j] = __expf(s1[j] - mn); ps += s0[j] + s1[j]; }
                l_[qs] = l_[qs] * alpha + ps;
                const u32x4 pw = {cvt_pk_bf16(s0[0], s0[1]), cvt_pk_bf16(s0[2], s0[3]), cvt_pk_bf16(s1[0], s1[1]), cvt_pk_bf16(s1[2], s1[3])};
                const bf16x8 pb = __builtin_bit_cast(bf16x8, pw);
#pragma unroll
                for (int ds = 0; ds < 4; ++ds) { o[qs][ds] = o[qs][ds] * alpha; o[qs][ds] = __builtin_amdgcn_mfma_f32_16x16x32_bf16(vreg[ds], pb, o[qs][ds], 0, 0, 0); }
            }
        }
    }
#pragma unroll
    for (int qs = 0; qs < 4; ++qs) { float lt = l_[qs]; lt += __shfl_xor(lt, 16); lt += __shfl_xor(lt, 32); const float inv = 1.0f / lt;
        bf16_t* dst = MIX + (size_t)(row0 + qoff + qs * 16 + fr) * 1024 + h * 64 + 4 * fq;
#pragma unroll
        for (int ds = 0; ds < 4; ++ds) { const f32x4 v = o[qs][ds] * inv; u32x2 w; w.x = cvt_pk_bf16(v[0], v[1]); w.y = cvt_pk_bf16(v[2], v[3]); *(u32x2*)(dst + ds * 16) = w; } }
}

__device__ __forceinline__ void conv_item(const Params& p, LAS unsigned char* lds, int ci) {
    const int tid = threadIdx.x, lane = tid & 63, wid = tid >> 6;
    const bf16_t* U = (const bf16_t*)(p.ws + WS_U); bf16_t* MIX = (bf16_t*)(p.ws + WS_MIX);
    const int row0 = ci * 32;
    int s0, s1; if (row0 < MCTX) { s0 = row0 & ~255; s1 = s0 + 256; } else { s0 = MCTX + ((row0 - MCTX) & ~2047); s1 = s0 + 2048; }
    __syncthreads();
    for (int pc = tid; pc < 62 * 64; pc += 512) { const int rr = pc >> 6, c8 = pc & 63, grow = row0 - 15 + rr; u32x4 v = {0u, 0u, 0u, 0u};
        if (grow >= s0 && grow < s1) v = *(const u32x4*)(U + (size_t)grow * 512 + c8 * 8);
        *(LAS u32x4*)(lds + rr * 1024 + c8 * 16) = v; }
    __syncthreads();
    const int cp = tid & 255, th = tid >> 8;
    float w0[31], w1[31];
#pragma unroll
    for (int k = 0; k < 31; ++k) { const f32x2 wv = *(const f32x2*)(p.in[16] + k * 512 + 2 * cp); w0[k] = wv.x; w1[k] = wv.y; }
    const f32x2 bv = *(const f32x2*)(p.in[17] + 2 * cp);
    LAS f32x2* zb = (LAS f32x2*)(lds + 65536);
#pragma unroll 1
    for (int tt = 0; tt < 16; ++tt) { const int t = th * 16 + tt; float a0 = bv.x, a1 = bv.y;
#pragma unroll
        for (int k = 0; k < 31; ++k) { const unsigned x = *(const LAS unsigned*)(lds + (t + k) * 1024 + cp * 4); a0 += w0[k] * bflo(x); a1 += w1[k] * bfhi(x); }
        zb[t * 256 + cp] = (f32x2){a0, a1}; }
    __syncthreads();
    const f32x4 g0 = *(const f32x4*)(p.in[18] + lane * 8), g1 = *(const f32x4*)(p.in[18] + lane * 8 + 4), be0 = *(const f32x4*)(p.in[19] + lane * 8), be1 = *(const f32x4*)(p.in[19] + lane * 8 + 4);
#pragma unroll 1
    for (int q = 0; q < 4; ++q) { const int t = wid * 4 + q;
        const LAS float* zr = (const LAS float*)(lds + 65536 + t * 2048);
        f32x4 v0 = *(const LAS f32x4*)(zr + lane * 8), v1 = *(const LAS f32x4*)(zr + lane * 8 + 4);
        float s = (v0[0] + v0[1]) + (v0[2] + v0[3]) + (v1[0] + v1[1]) + (v1[2] + v1[3]);
#pragma unroll
        for (int o = 32; o >= 1; o >>= 1) s += __shfl_xor(s, o);
        const float mean = s * (1.0f / 512.0f);
        v0 = v0 - mean; v1 = v1 - mean;
        float qv = (v0[0] * v0[0] + v0[1] * v0[1]) + (v0[2] * v0[2] + v0[3] * v0[3]) + (v1[0] * v1[0] + v1[1] * v1[1]) + (v1[2] * v1[2] + v1[3] * v1[3]);
#pragma unroll
        for (int o = 32; o >= 1; o >>= 1) qv += __shfl_xor(qv, o);
        const float rstd = rsqrtf(qv * (1.0f / 512.0f) + 1e-6f);
        v0 = v0 * rstd * g0 + be0; v1 = v1 * rstd * g1 + be1;
#pragma unroll
        for (int j = 0; j < 4; ++j) { v0[j] = v0[j] * sigmoidf_(v0[j]); v1[j] = v1[j] * sigmoidf_(v1[j]); }
        u32x4 w; w.x = cvt_pk_bf16(v0[0], v0[1]); w.y = cvt_pk_bf16(v0[2], v0[3]); w.z = cvt_pk_bf16(v1[0], v1[1]); w.w = cvt_pk_bf16(v1[2], v1[3]);
        *(u32x4*)(MIX + (size_t)(row0 + t) * 1024 + 512 + lane * 8) = w; }
}

__device__ __forceinline__ void phase_conv4(const Params& p) {
    const bf16_t* R = (const bf16_t*)(p.ws + WS_R); bf16_t* XC = (bf16_t*)(p.ws + WS_HA);
    for (int idx = blockIdx.x * 512 + threadIdx.x; idx < MT * 128; idx += gridDim.x * 512) {
        const int row = idx >> 7, c8 = idx & 127;
        int s0, s1; if (row < MCTX) { s0 = row & ~255; s1 = s0 + 256; } else { s0 = MCTX + ((row - MCTX) & ~2047); s1 = s0 + 2048; }
        f32x4 a0 = *(const f32x4*)(p.in[23] + c8 * 8), a1 = *(const f32x4*)(p.in[23] + c8 * 8 + 4);
#pragma unroll
        for (int k = 0; k < 4; ++k) { const int rr = row + k - 1;
            if (rr >= s0 && rr < s1) { const u32x4 x = *(const u32x4*)(R + (size_t)rr * 1024 + c8 * 8);
                const f32x4 w0 = *(const f32x4*)(p.in[22] + k * 1024 + c8 * 8), w1 = *(const f32x4*)(p.in[22] + k * 1024 + c8 * 8 + 4);
                a0[0] += w0[0] * bflo(x.x); a0[1] += w0[1] * bfhi(x.x); a0[2] += w0[2] * bflo(x.y); a0[3] += w0[3] * bfhi(x.y);
                a1[0] += w1[0] * bflo(x.z); a1[1] += w1[1] * bfhi(x.z); a1[2] += w1[2] * bflo(x.w); a1[3] += w1[3] * bfhi(x.w); } }
        u32x4 w; w.x = cvt_pk_bf16(a0[0], a0[1]); w.y = cvt_pk_bf16(a0[2], a0[3]); w.z = cvt_pk_bf16(a1[0], a1[1]); w.w = cvt_pk_bf16(a1[2], a1[3]);
        *(u32x4*)(XC + (size_t)row * 1024 + c8 * 8) = w;
    }
}

constexpr int CH = 64, NCHUNK = MT / CH;
__device__ __forceinline__ void phase_scan_sum(const Params& p) {
    const unsigned* LB = (const unsigned*)(p.ws + WS_LB); float* SUM = (float*)(p.ws + WS_SUM);
    const int cp = threadIdx.x;
    for (int bi = blockIdx.x; bi < NCHUNK * 2; bi += gridDim.x) {
        const int c = bi >> 1, dir = bi & 1;
        const unsigned* base = LB + ((size_t)dir * MT + (size_t)c * CH) * 1024 + 2 * cp;
        float A0 = 1.f, A1 = 1.f, B0 = 0.f, B1 = 0.f;
#pragma unroll 8
        for (int i = 0; i < CH; ++i) { const int t = dir ? (CH - 1 - i) : i; const u32x2 w = *(const u32x2*)(base + (size_t)t * 1024);
            const float a0 = __expf(bflo(w.x)), a1 = __expf(bflo(w.y)); B0 = a0 * B0 + bfhi(w.x); B1 = a1 * B1 + bfhi(w.y); A0 *= a0; A1 *= a1; }
        *(f32x4*)(SUM + ((size_t)(c * 2 + dir) * 1024 + 2 * cp) * 2) = (f32x4){A0, B0, A1, B1};
    }
}

__device__ __forceinline__ void phase_scan_final(const Params& p) {
    unsigned* LB = (unsigned*)(p.ws + WS_LB); const float* SUM = (const float*)(p.ws + WS_SUM);
    const unsigned* G = (const unsigned*)(p.ws + WS_G); unsigned* YA = (unsigned*)(p.ws + WS_R);
    float* outh = p.out + 13631488;
    const int cp = threadIdx.x;
    for (int c = blockIdx.x; c < NCHUNK; c += gridDim.x) {
        const int row0 = c * CH; const bool ctx = row0 < MCTX;
        int cs0, ncs, b; if (ctx) { b = row0 >> 8; cs0 = b * 4; ncs = 4; } else { b = (row0 - MCTX) >> 11; cs0 = 64 + b * 32; ncs = 32; }
        float hf0 = 0.f, hf1 = 0.f, hb0 = 0.f, hb1 = 0.f;
        if (!ctx) { const f32x2 f = *(const f32x2*)(p.in[5] + (size_t)(b * 2 + 0) * 1024 + 2 * cp), bk = *(const f32x2*)(p.in[5] + (size_t)(b * 2 + 1) * 1024 + 2 * cp); hf0 = f.x; hf1 = f.y; hb0 = bk.x; hb1 = bk.y; }
        for (int cc = cs0; cc < c; ++cc) { const f32x4 s = *(const f32x4*)(SUM + ((size_t)(cc * 2 + 0) * 1024 + 2 * cp) * 2); hf0 = s[0] * hf0 + s[1]; hf1 = s[2] * hf1 + s[3]; }
        for (int cc = cs0 + ncs - 1; cc > c; --cc) { const f32x4 s = *(const f32x4*)(SUM + ((size_t)(cc * 2 + 1) * 1024 + 2 * cp) * 2); hb0 = s[0] * hb0 + s[1]; hb1 = s[2] * hb1 + s[3]; }
        unsigned* lf = LB + ((size_t)row0) * 1024 + 2 * cp;
        const unsigned* lb = LB + ((size_t)MT + row0) * 1024 + 2 * cp;
#pragma unroll 8
        for (int t = 0; t < CH; ++t) { const u32x2 w = *(const u32x2*)(lf + (size_t)t * 1024);
            hf0 = __expf(bflo(w.x)) * hf0 + bfhi(w.x); hf1 = __expf(bflo(w.y)) * hf1 + bfhi(w.y);
            *(f32x2*)(lf + (size_t)t * 1024) = (f32x2){hf0, hf1}; }
        if (ctx && c == cs0 + ncs - 1) *(f32x2*)(outh + (size_t)(b * 2 + 0) * 1024 + 2 * cp) = (f32x2){hf0, hf1};
#pragma unroll 8
        for (int t = CH - 1; t >= 0; --t) { const u32x2 w = *(const u32x2*)(lb + (size_t)t * 1024);
            hb0 = __expf(bflo(w.x)) * hb0 + bfhi(w.x); hb1 = __expf(bflo(w.y)) * hb1 + bfhi(w.y);
            const f32x2 hf = *(const f32x2*)(lf + (size_t)t * 1024); const unsigned gw = G[(size_t)(row0 + t) * 512 + cp];
            YA[(size_t)(row0 + t) * 512 + cp] = cvt_pk_bf16((hf.x + hb0) * bflo(gw), (hf.y + hb1) * bfhi(gw)); }
        if (ctx && c == cs0) *(f32x2*)(outh + (size_t)(b * 2 + 1) * 1024 + 2 * cp) = (f32x2){hb0, hb1};
    }
}

__global__ void __launch_bounds__(512, 2) mega(Params p) {
    extern __shared__ __attribute__((aligned(16))) unsigned char lds_raw[];
    LAS unsigned char* lds = (LAS unsigned char*)lds_raw;
    cg::grid_group grid = cg::this_grid();
    unsigned char* ws = p.ws;
    const float* mod0 = (const float*)(ws + WS_MOD); const float* mod1 = mod0 + 5 * 6144;
    bf16_t* HA = (bf16_t*)(ws + WS_HA);
    const int G_ = gridDim.x, bx = blockIdx.x;
#define PH_BEGIN(k) if (p.ph_lo <= (k) && (k) < p.ph_hi) {
#define PH_END(k) if ((k) + 1 < p.ph_hi) grid.sync(); }
    PH_BEGIN(0) phase_prep(p, lds); PH_END(0)
    PH_BEGIN(1) phase_norm<0>(p, p.in[9], mod0, 0, 1); PH_END(1)
    PH_BEGIN(2) { pg8::Gemm g{HA, (const bf16_t*)(ws + WS_WATTIN), MT, 1792, 1024, 1024, 1024, 30, 0}; pg8::StaticOrder S; S.init(MT, 1792, G_, bx);
                  EpiQKVU E{(bf16_t*)(ws + WS_Q), (bf16_t*)(ws + WS_KB), (bf16_t*)(ws + WS_VTL), (bf16_t*)(ws + WS_VTC), (bf16_t*)(ws + WS_U), p.out + 12582912, p.out + 13107200};
                  pg8::gemm_phase(lds, g, S, E); } PH_END(2)
    PH_BEGIN(3) { int it = bx; for (; it < 192; it += G_) attn_item(p, lds, it); for (; it < 192 + 384; it += G_) conv_item(p, lds, it - 192); } PH_END(3)
    PH_BEGIN(4) { pg8::Gemm g{(const bf16_t*)(ws + WS_MIX), (const bf16_t*)(ws + WS_WATTOUT), MT, 1024, 1024, 1024, 1024, 30, 0}; pg8::StaticOrder S; S.init(MT, 1024, G_, bx);
                  EpiResid<true> E{p.in[0], p.in[1], p.out, mod0 + 2 * 1024}; pg8::gemm_phase(lds, g, S, E); } PH_END(4)
    PH_BEGIN(5) phase_norm<1>(p, p.in[10], mod0, 3, 4); PH_END(5)
    PH_BEGIN(6) { pg8::Gemm g{HA, (const bf16_t*)(ws + WS_WFF1), MT, 4096, 1024, 1024, 1024, 30, 0}; pg8::StaticOrder S; S.init(MT, 4096, G_, bx);
                  EpiSqRelu E{(bf16_t*)(ws + WS_F)}; pg8::gemm_phase(lds, g, S, E); } PH_END(6)
    PH_BEGIN(7) { pg8::Gemm g{(const bf16_t*)(ws + WS_F), (const bf16_t*)(ws + WS_WFF2), MT, 1024, 4096, 4096, 4096, 30, 0}; pg8::StaticOrder S; S.init(MT, 1024, G_, bx);
                  EpiResid<false> E{nullptr, nullptr, p.out, mod0 + 5 * 1024}; pg8::gemm_phase(lds, g, S, E); } PH_END(7)
    PH_BEGIN(8) phase_norm<1>(p, p.in[9] + 1024, mod1, 0, 1); PH_END(8)
    PH_BEGIN(9) { pg8::Gemm g{HA, (const bf16_t*)(ws + WS_WLRUIN), MT, 2048, 1024, 1024, 1024, 30, 0}; pg8::StaticOrder S; S.init(MT, 2048, G_, bx);
                  EpiLruIn E{(bf16_t*)(ws + WS_G), (bf16_t*)(ws + WS_R)}; pg8::gemm_phase(lds, g, S, E); } PH_END(9)
    PH_BEGIN(10) phase_conv4(p); PH_END(10)
    PH_BEGIN(11) { int k11 = 128; asm volatile("" : "+s"(k11));
                   pg8::Gemm g{HA, (const bf16_t*)(ws + WS_WG), MT, 4096, k11, 1024, 128, 1, 256}; pg8::StaticOrder S; S.init(MT, 4096, G_, bx);
                   EpiGates E{HA, (unsigned*)(ws + WS_LB), p.in[25], p.in[27], p.in[28]}; pg8::gemm_phase(lds, g, S, E); } PH_END(11)
    PH_BEGIN(12) phase_scan_sum(p); PH_END(12)
    PH_BEGIN(13) phase_scan_final(p); PH_END(13)
    PH_BEGIN(14) { pg8::Gemm g{(const bf16_t*)(ws + WS_R), (const bf16_t*)(ws + WS_WLRUOUT), MT, 1024, 1024, 1024, 1024, 30, 0}; pg8::StaticOrder S; S.init(MT, 1024, G_, bx);
                   EpiResid<false> E{nullptr, nullptr, p.out, mod1 + 2 * 1024}; pg8::gemm_phase(lds, g, S, E); } PH_END(14)
    PH_BEGIN(15) phase_norm<1>(p, p.in[10] + 1024, mod1, 3, 4); PH_END(15)
    PH_BEGIN(16) { pg8::Gemm g{HA, (const bf16_t*)(ws + WS_WFF1) + (size_t)4096 * 1024, MT, 4096, 1024, 1024, 1024, 30, 0}; pg8::StaticOrder S; S.init(MT, 4096, G_, bx);
                   EpiSqRelu E{(bf16_t*)(ws + WS_F)}; pg8::gemm_phase(lds, g, S, E); } PH_END(16)
    PH_BEGIN(17) { pg8::Gemm g{(const bf16_t*)(ws + WS_F), (const bf16_t*)(ws + WS_WFF2) + (size_t)1024 * 4096, MT, 1024, 4096, 4096, 4096, 30, 0}; pg8::StaticOrder S; S.init(MT, 1024, G_, bx);
                   EpiResid<false> E{nullptr, nullptr, p.out, mod1 + 5 * 1024}; pg8::gemm_phase(lds, g, S, E); } PH_END(17)
    PH_BEGIN(18) phase_norm<2>(p, p.in[29], mod0, 0, 0); PH_END(18)
}

extern "C" void kernel_launch(void* const* d_in, const int* in_sizes, int n_in, void* d_out, int out_size, void* d_ws, size_t ws_size, hipStream_t stream) {
    static int grid = 0;
    if (grid == 0) {
        if (n_in != 30 || out_size != 13664256 || ws_size < WS_END) { fprintf(stderr, "kernel_launch: unexpected problem (n_in %d out %d ws %zu)\n", n_in, out_size, ws_size); grid = -1; return; }
        int dev = 0, cus = 0, per_cu = 0;
        if (hipGetDevice(&dev) != hipSuccess || hipDeviceGetAttribute(&cus, hipDeviceAttributeMultiprocessorCount, dev) != hipSuccess) { grid = -1; return; }
        if (hipFuncSetAttribute((const void*)mega, hipFuncAttributeMaxDynamicSharedMemorySize, LDS_BYTES) != hipSuccess) { fprintf(stderr, "kernel_launch: hipFuncSetAttribute failed\n"); grid = -1; return; }
        if (hipOccupancyMaxActiveBlocksPerMultiprocessor(&per_cu, (const void*)mega, 512, LDS_BYTES) != hipSuccess || per_cu < 1) { fprintf(stderr, "kernel_launch: occupancy query says %d blocks per CU\n", per_cu); grid = -1; return; }
        grid = cus;
    }
    if (grid < 0) return;
    Params p{};
    for (int i = 0; i < 30; ++i) p.in[i] = (const float*)d_in[i];
    p.out = (float*)d_out; p.ws = (unsigned char*)d_ws;
#if N_LAUNCH_MODE == 1
    p.ph_lo = 0; p.ph_hi = NPH;
    void* args[] = {&p};
    hipError_t e = hipLaunchCooperativeKernel((const void*)mega, dim3(grid), dim3(512), args, LDS_BYTES, stream);
    if (e != hipSuccess) fprintf(stderr, "cooperative launch failed: %s (grid %d)\n", hipGetErrorString(e), grid);
#else
    for (int ph = 0; ph < NPH; ++ph) { p.ph_lo = ph; p.ph_hi = ph + 1; hipLaunchKernelGGL(mega, dim3(grid), dim3(512), LDS_BYTES, stream, p); }
#endif
}
```

```cpp
#include <hip/hip_runtime.h>
#include <hip/hip_cooperative_groups.h>
#include <cstdio>
#include <cstdint>
namespace cg = cooperative_groups;

#ifndef N_LAUNCH_MODE
#define N_LAUNCH_MODE 1
#endif

#define LAS __attribute__((address_space(3)))
typedef unsigned short bf16_t;
typedef short bf16x8 __attribute__((ext_vector_type(8)));
typedef float f32x4 __attribute__((ext_vector_type(4)));
typedef float f32x2 __attribute__((ext_vector_type(2)));
typedef unsigned u32x4 __attribute__((ext_vector_type(4)));
typedef unsigned u32x2 __attribute__((ext_vector_type(2)));

constexpr int MT = 12288, MCTX = 4096, DM = 1024;
constexpr int NPH = 19;
constexpr size_t MiB = 1024 * 1024;
constexpr size_t WS_MOD = 0;
constexpr size_t WS_SUM = 256 * 1024;
constexpr size_t WS_CK = WS_SUM + 3 * MiB;
constexpr size_t WS_CVT = WS_CK + 256 * 1024;
constexpr size_t WS_WATTIN = 4 * MiB;
constexpr size_t WS_WATTOUT = WS_WATTIN + 3584 * 1024;
constexpr size_t WS_WFF1 = WS_WATTOUT + 2 * MiB;
constexpr size_t WS_WFF2 = WS_WFF1 + 16 * MiB;
constexpr size_t WS_WLRUIN = WS_WFF2 + 16 * MiB;
constexpr size_t WS_WLRUOUT = WS_WLRUIN + 4 * MiB;
constexpr size_t WS_WG = WS_WLRUOUT + 2 * MiB;
constexpr size_t WS_HA = 49 * MiB;
constexpr size_t WS_G = 73 * MiB;
constexpr size_t WS_R = 97 * MiB;
constexpr size_t WS_F = 121 * MiB;
constexpr size_t WS_END = 217 * MiB;
constexpr size_t WS_Q = WS_F;
constexpr size_t WS_KB = WS_F + 12 * MiB;
constexpr size_t WS_VTL = WS_F + 15 * MiB;
constexpr size_t WS_VTC = WS_F + 17 * MiB;
constexpr size_t WS_U = WS_F + 18 * MiB;
constexpr size_t WS_MIX = WS_F + 30 * MiB;
constexpr size_t WS_LB = WS_F;
static_assert(WS_WG + 1 * MiB <= WS_HA, "weights overflow");

constexpr int LDS_BYTES = 131072 + 64;
constexpr size_t WS_BAR = 245760;

struct Params {
    const float* in[30];
    float* out;
    unsigned char* ws;
    int ph_lo, ph_hi;
};

__device__ __forceinline__ unsigned cvt_pk_bf16(float lo, float hi) { unsigned r; asm volatile("v_cvt_pk_bf16_f32 %0, %1, %2" : "=v"(r) : "v"(lo), "v"(hi)); return r; }
__device__ __forceinline__ float bflo(unsigned w) { return __uint_as_float(w << 16); }
__device__ __forceinline__ float bfhi(unsigned w) { return __uint_as_float(w & 0xffff0000u); }
__device__ __forceinline__ float sigmoidf_(float x) { return 1.0f / (1.0f + __expf(-x)); }


#define XB_TMO      128
#define XB_XCNT(j)  (256  + 64 * (j))
#define XB_XSUB(j)  (1280 + 64 * (j))
#define XB_XGEN(j)  (2304 + 64 * (j))
#define XB_TOP      3328
#define XB_TOPGEN   3392
#define XCD_BAR_WORDS 3456
#define XB_SPIN_CAP (1u << 18)
__device__ __forceinline__ unsigned xb_ld(unsigned* p)              { return __hip_atomic_load(p, __ATOMIC_RELAXED, __HIP_MEMORY_SCOPE_AGENT); }
__device__ __forceinline__ unsigned xb_add(unsigned* p, unsigned v) { return __hip_atomic_fetch_add(p, v, __ATOMIC_RELAXED, __HIP_MEMORY_SCOPE_AGENT); }
__device__ __forceinline__ unsigned xb_xcc_id() { return (unsigned)__builtin_amdgcn_s_getreg((3 << 11) | 20) & 0xFu; }
#define XB_SPIN(cond, bar) do { unsigned _sp = 0; while (cond) { __builtin_amdgcn_s_sleep(1); \
    if ((++_sp & 255u) == 0u) { if (xb_ld(&(bar)[XB_TMO])) break; if (_sp > XB_SPIN_CAP) { atomicAdd(&(bar)[XB_TMO], 1u); break; } } } } while (0)
struct XcdBarrier { unsigned* bar; unsigned x; volatile LAS unsigned* st; };
__device__ __forceinline__ XcdBarrier xcd_barrier_post(unsigned* bar, volatile LAS unsigned* st) {
    XcdBarrier b; b.bar = bar; b.x = xb_xcc_id(); b.st = st;
    if (threadIdx.x == 0) (void)xb_add(&bar[XB_XCNT(b.x)], 1u);
    return b;
}
__device__ __forceinline__ void xcd_barrier_complete(unsigned* bar, unsigned x, unsigned& nloc, unsigned& nx) {
    const unsigned G = gridDim.x * gridDim.y * gridDim.z;
    unsigned sum, cnt, mine, sp = 0u;
    for (;;) {
        sum = 0u; cnt = 0u; mine = 0u;
#pragma unroll
        for (unsigned j = 0; j < 16; ++j) { const unsigned c = xb_ld(&bar[XB_XCNT(j)]); sum += c; cnt += (c > 0u) ? 1u : 0u; mine = (j == x) ? c : mine; }
        if (sum == G) break;
        __builtin_amdgcn_s_sleep(1);
        if ((++sp & 255u) == 0u) { if (xb_ld(&bar[XB_TMO])) break; if (sp > XB_SPIN_CAP) { atomicAdd(&bar[XB_TMO], 1u); break; } }
    }
    nloc = mine > 0u ? mine : 1u; nx = cnt > 0u ? cnt : 1u;
}
__device__ __forceinline__ void xcd_barrier(const XcdBarrier& b) {
    asm volatile("s_waitcnt vmcnt(0)" ::: "memory");
    __syncthreads();
    if (threadIdx.x == 0) {
        unsigned* bar = b.bar;
        __builtin_amdgcn_s_waitcnt(0);
        unsigned nloc = b.st[0], nx = b.st[1];
        if (nloc == 0u) { xcd_barrier_complete(bar, b.x, nloc, nx); b.st[0] = nloc; b.st[1] = nx; }
        const unsigned old = xb_add(&bar[XB_XSUB(b.x)], 1u);
        const unsigned gen = old / nloc;
        if (old + 1u == (gen + 1u) * nloc) {
            __builtin_amdgcn_fence(__ATOMIC_RELEASE, "agent");
            asm volatile("s_waitcnt vmcnt(0)" ::: "memory");
            const unsigned og = xb_add(&bar[XB_TOP], 1u);
            const unsigned tg = og / nx;
            if (og + 1u == (tg + 1u) * nx) xb_add(&bar[XB_TOPGEN], 1u);
            else XB_SPIN(xb_ld(&bar[XB_TOPGEN]) == tg, bar);
            __builtin_amdgcn_fence(__ATOMIC_ACQUIRE, "agent");
            xb_add(&bar[XB_XGEN(b.x)], 1u);
            asm volatile("s_waitcnt vmcnt(0)" ::: "memory");
        } else {
            XB_SPIN(xb_ld(&bar[XB_XGEN(b.x)]) == gen, bar);
            __builtin_amdgcn_fence(__ATOMIC_ACQUIRE, "agent");
            asm volatile("s_waitcnt vmcnt(0)" ::: "memory");
        }
    }
    __syncthreads();
}

namespace pg8 {
constexpr int BM = 256, BK = 64, HALF = 128, HTB = HALF * BK * 2, STAGE_BYTES = 8 * HTB, NXCD = 8, WGM = 8;
__host__ __device__ __forceinline__ int lds_byte(int r, int c) { const int st = (r >> 4) * 2 + (c >> 5), rr = r & 15, cc = c & 31, ob = rr * 64 + cc * 2; return st * 1024 + (ob ^ (((ob >> 9) & 1) << 5)); }
__host__ __device__ __forceinline__ void stage_rc(int b, int& R, int& C) { const int st = b / 1024, sb = b % 1024, swz = sb ^ (((sb >> 9) & 1) << 5); R = (st >> 1) * 16 + swz / 64; C = (st & 1) * 32 + (swz % 64) / 2; }
__host__ __device__ __forceinline__ int perm32(int rho) { const int n = rho >> 4, i = rho & 15; return 8 * (i >> 2) + 4 * n + (i & 3); }

struct Unit { int pm, pn; };
struct Gemm { const bf16_t* A; const bf16_t* Bt; int M, N, K, lda, ldb, gshift, goff; };

struct StaticOrder {
    int nM, nN, nwg, G, c;
    __host__ __device__ void init(int M, int N, int G_, int c_) { nM = M / BM; nN = N / BM; nwg = nM * nN; G = G_; c = c_; }
    __host__ __device__ bool next(int i, Unit& u) const {
        const long L = (long)i * G + c; if (L >= nwg) return false;
        int wgid = (int)L; { const int q = nwg / NXCD, r = nwg % NXCD, xcd = wgid % NXCD, off = wgid / NXCD; wgid = (xcd < r ? xcd * (q + 1) : r * (q + 1) + (xcd - r) * q) + off; }
        const int nig = WGM * nN, gid = wgid / nig, fm = gid * WGM, gsz = (nM - fm) < WGM ? (nM - fm) : WGM;
        u.pm = fm + ((wgid % nig) % gsz); u.pn = (wgid % nig) / gsz; return true;
    }
};

template <class Epi>
__device__ __forceinline__ void gemm_phase(LAS unsigned char* lds, const Gemm g, const StaticOrder& S, const Epi& E) {
    const int tid = threadIdx.x, wid = __builtin_amdgcn_readfirstlane(tid >> 6), lane = tid & 63, wr = wid >> 2, wc = wid & 3, fr = lane & 15, fq = lane >> 4;
    const int K = g.K, nt = K / BK;
    unsigned voffA[2], voffB[2];
#pragma unroll
    for (int i = 0; i < 2; ++i) { int R, C; stage_rc(tid * 16 + i * 8192, R, C); const int Rb = Epi::PERM ? ((R & ~31) + perm32(R & 31)) : R;
        voffA[i] = (unsigned)(R * g.lda + C) * 2u; voffB[i] = (unsigned)(Rb * g.ldb + C) * 2u; }
    const size_t kstep = (size_t)(BK * 2);
    const size_t hstepA = (size_t)HALF * g.lda * 2, hstepB = (size_t)HALF * g.ldb * 2;
    const size_t tstepA = 2 * hstepA, tstepB = 2 * hstepB;
    const unsigned ldsw = (unsigned)wid * 1024u;
    const int aoff = lds_byte(wr * 64 + fr, fq * 8), boff = lds_byte(wc * 32 + fr, fq * 8);
#define PG8_SA(b, h) (((b) * 2 + (h)) * HTB)
#define PG8_SB(b, h) ((4 + (b) * 2 + (h)) * HTB)
#define PG8_STAGE(bufoff, gbase, voff) do { _Pragma("unroll") for (int _i = 0; _i < 2; ++_i) \
        __builtin_amdgcn_global_load_lds((const unsigned*)((const char*)(gbase) + (voff)[_i]), (LAS unsigned*)(lds + (bufoff) + ldsw + _i * 8192), 16, 0, 0); } while (0)
#define PG8_LDA(dst, b, h) do { _Pragma("unroll") for (int m = 0; m < 4; ++m) _Pragma("unroll") for (int k = 0; k < 2; ++k) dst[m][k] = *(const LAS bf16x8*)(lds + PG8_SA(b, h) + aoff + m * 2048 + k * 1024); } while (0)
#define PG8_LDB(dst, b, h) do { _Pragma("unroll") for (int n = 0; n < 2; ++n) _Pragma("unroll") for (int k = 0; k < 2; ++k) dst[n][k] = *(const LAS bf16x8*)(lds + PG8_SB(b, h) + boff + n * 2048 + k * 1024); } while (0)
#define PG8_MMA(ai, bj, At, Bt) do { __builtin_amdgcn_s_setprio(1); _Pragma("unroll") for (int m = 0; m < 4; ++m) _Pragma("unroll") for (int n = 0; n < 2; ++n) _Pragma("unroll") for (int k = 0; k < 2; ++k) \
        acc[ai][bj][m][n] = __builtin_amdgcn_mfma_f32_16x16x32_bf16(Bt[n][k], At[m][k], acc[ai][bj][m][n], 0, 0, 0); __builtin_amdgcn_s_setprio(0); } while (0)
#define PG8_WAIT_V(n) asm volatile("s_waitcnt vmcnt(" #n ")" ::: "memory")
#define PG8_WAIT_L(n) asm volatile("s_waitcnt lgkmcnt(" #n ")" ::: "memory")
#define PG8_BAR __builtin_amdgcn_s_barrier()
#define PG8_SCHED __builtin_amdgcn_sched_barrier(0)
    Unit cur, nxt; int ui = 0;
    if (!S.next(0, cur)) return;
    f32x4 acc[2][2][4][2];
#pragma unroll
    for (int a = 0; a < 2; ++a)
#pragma unroll
        for (int b = 0; b < 2; ++b)
#pragma unroll
            for (int m = 0; m < 4; ++m)
#pragma unroll
                for (int n = 0; n < 2; ++n) acc[a][b][m][n] = (f32x4){0.f, 0.f, 0.f, 0.f};
    bf16x8 At[4][2], B0[2][2], B1[2][2];
    const char* cA = (const char*)g.A + (size_t)cur.pm * tstepA + (size_t)(cur.pn >> g.gshift) * g.goff; const char* cB = (const char*)g.Bt + (size_t)cur.pn * tstepB;
    PG8_STAGE(PG8_SB(0, 0), cB, voffB); PG8_STAGE(PG8_SB(0, 1), cB + hstepB, voffB); PG8_STAGE(PG8_SA(0, 0), cA, voffA); PG8_STAGE(PG8_SA(0, 1), cA + hstepA, voffA);
    if (wr == 1) PG8_BAR;
    PG8_WAIT_V(2); PG8_BAR;
    PG8_STAGE(PG8_SB(1, 0), cB + kstep, voffB); PG8_STAGE(PG8_SA(1, 0), cA + kstep, voffA); PG8_STAGE(PG8_SB(1, 1), cB + hstepB + kstep, voffB);
    PG8_WAIT_V(6); PG8_BAR;
    for (;;) {
        const bool has_next = S.next(ui + 1, nxt);
        const char* nA = has_next ? (const char*)g.A + (size_t)nxt.pm * tstepA + (size_t)(nxt.pn >> g.gshift) * g.goff : cA; const char* nB = has_next ? (const char*)g.Bt + (size_t)nxt.pn * tstepB : cB;
        for (int t = 0; t < nt; t += 2) {
            const bool last = (t == nt - 2);
            const char* a1 = cA + (size_t)(t + 1) * kstep;
            const char* a2 = last ? nA : cA + (size_t)(t + 2) * kstep; const char* b2 = last ? nB : cB + (size_t)(t + 2) * kstep;
            const char* a3 = a2 + kstep; const char* b3 = b2 + kstep;
            PG8_LDB(B0, 0, 0); PG8_LDB(B1, 0, 1); PG8_SCHED; PG8_LDA(At, 0, 0); PG8_STAGE(PG8_SA(1, 1), a1 + hstepA, voffA);
            PG8_WAIT_V(8); PG8_WAIT_L(0); PG8_BAR; PG8_MMA(0, 0, At, B0); PG8_MMA(0, 1, At, B1); PG8_BAR; PG8_SCHED;
            PG8_LDA(At, 0, 1); PG8_STAGE(PG8_SB(0, 0), b2, voffB); PG8_STAGE(PG8_SB(0, 1), b2 + hstepB, voffB); PG8_STAGE(PG8_SA(0, 0), a2, voffA);
            PG8_WAIT_V(8); PG8_WAIT_L(0); PG8_BAR; PG8_MMA(1, 0, At, B0); PG8_MMA(1, 1, At, B1); PG8_BAR; PG8_SCHED;
            PG8_LDB(B0, 1, 0); PG8_LDB(B1, 1, 1); PG8_SCHED; PG8_LDA(At, 1, 0); PG8_STAGE(PG8_SA(0, 1), a2 + hstepA, voffA);
            PG8_WAIT_V(8); PG8_WAIT_L(0); PG8_BAR; PG8_MMA(0, 0, At, B0); PG8_MMA(0, 1, At, B1); PG8_BAR; PG8_SCHED;
            PG8_LDA(At, 1, 1); PG8_STAGE(PG8_SB(1, 0), b3, voffB); PG8_STAGE(PG8_SB(1, 1), b3 + hstepB, voffB); PG8_STAGE(PG8_SA(1, 0), a3, voffA);
            PG8_WAIT_V(8); PG8_WAIT_L(0); PG8_BAR; PG8_MMA(1, 0, At, B0); PG8_MMA(1, 1, At, B1); PG8_BAR; PG8_SCHED;
        }
        if (wr == 0) PG8_BAR;
        E(acc, cur, wr, wc, fr, fq);
        if (!has_next) break;
#pragma unroll
        for (int a = 0; a < 2; ++a)
#pragma unroll
            for (int b = 0; b < 2; ++b)
#pragma unroll
                for (int m = 0; m < 4; ++m)
#pragma unroll
                    for (int n = 0; n < 2; ++n) acc[a][b][m][n] = (f32x4){0.f, 0.f, 0.f, 0.f};
        cur = nxt; cA = nA; cB = nB; ++ui;
        if (wr == 1) PG8_BAR;
    }
    PG8_WAIT_V(0);
    PG8_BAR;
#undef PG8_SA
#undef PG8_SB
#undef PG8_STAGE
#undef PG8_LDA
#undef PG8_LDB
#undef PG8_MMA
#undef PG8_WAIT_V
#undef PG8_WAIT_L
#undef PG8_BAR
#undef PG8_SCHED
}
}
using pg8::Unit;

struct EpiQKVU {
    static constexpr bool PERM = false;
    bf16_t *Q, *Kb, *VtL, *VtC, *U; float *outk, *outv;
    __device__ __forceinline__ void operator()(const f32x4 (&acc)[2][2][4][2], const Unit& u, int wr, int wc, int fr, int fq) const {
        const int pn = u.pn; const bool lat = u.pm >= 16;
        const int rbase = u.pm * 256 + wr * 64 + fr;
        if (pn < 3) {
            float inv[4];
#pragma unroll
            for (int j = 0; j < 4; ++j) inv[j] = exp2f(-(float)(4 * fq + j) * 0.8304820237218406f);
#pragma unroll
            for (int ai = 0; ai < 2; ++ai)
#pragma unroll
                for (int m = 0; m < 4; ++m) {
                    const int r = rbase + ai * 128 + m * 16;
                    float cs[4], sn[4];
                    int t = 0, b = 0;
                    if (lat) { t = (r - MCTX) & 2047; b = (r - MCTX) >> 11; const float pos = (float)((wc & 1) ? (t & 63) : (t >> 6));
#pragma unroll
                        for (int j = 0; j < 4; ++j) { const float ang = pos * inv[j]; sn[j] = __sinf(ang); cs[j] = __cosf(ang); } }
                    else { t = r & 255; b = r >> 8;
#pragma unroll
                        for (int j = 0; j < 4; ++j) { sn[j] = 0.f; cs[j] = 1.f; } }
#pragma unroll
                    for (int bj = 0; bj < 2; ++bj) {
                        const f32x4 x1 = acc[ai][bj][m][0], x2 = acc[ai][bj][m][1];
                        if (pn == 2 && bj == 1) {
#pragma unroll
                            for (int n = 0; n < 2; ++n) {
                                const f32x4 x = n ? x2 : x1;
                                const int c0 = wc * 32 + n * 16 + 4 * fq;
#pragma unroll
                                for (int j = 0; j < 4; ++j) { const int c = c0 + j, kvh = c >> 6, d = c & 63;
                                    const bf16_t hv = (bf16_t)(cvt_pk_bf16(x[j], 0.f) & 0xffffu);
                                    if (lat) VtL[((size_t)((b * 2 + kvh) * 64 + d)) * 2048 + t] = hv; else VtC[((size_t)((b * 2 + kvh) * 64 + d)) * 256 + t] = hv; }
                                if (!lat) *(f32x4*)(outv + (size_t)r * 128 + c0) = x;
                            }
                        } else {
                            f32x4 o1, o2;
#pragma unroll
                            for (int j = 0; j < 4; ++j) { o1[j] = x1[j] * cs[j] - x2[j] * sn[j]; o2[j] = x2[j] * cs[j] + x1[j] * sn[j]; }
                            if (pn < 2) {
                                bf16_t* dst = Q + (size_t)r * 512 + pn * 256 + bj * 128 + wc * 32 + 4 * fq;
                                u32x2 w1, w2; w1.x = cvt_pk_bf16(o1[0] * 0.125f, o1[1] * 0.125f); w1.y = cvt_pk_bf16(o1[2] * 0.125f, o1[3] * 0.125f);
                                w2.x = cvt_pk_bf16(o2[0] * 0.125f, o2[1] * 0.125f); w2.y = cvt_pk_bf16(o2[2] * 0.125f, o2[3] * 0.125f);
                                *(u32x2*)dst = w1; *(u32x2*)(dst + 16) = w2;
                            } else {
                                const int c0 = wc * 32 + 4 * fq;
                                bf16_t* dst = Kb + (size_t)r * 128 + c0;
                                u32x2 w1, w2; w1.x = cvt_pk_bf16(o1[0], o1[1]); w1.y = cvt_pk_bf16(o1[2], o1[3]); w2.x = cvt_pk_bf16(o2[0], o2[1]); w2.y = cvt_pk_bf16(o2[2], o2[3]);
                                *(u32x2*)dst = w1; *(u32x2*)(dst + 16) = w2;
                                if (!lat) { *(f32x4*)(outk + (size_t)r * 128 + c0) = o1; *(f32x4*)(outk + (size_t)r * 128 + c0 + 16) = o2; }
                            }
                        }
                    }
                }
        } else {
            const int chb = (pn - 3) * 128 + wc * 32 + 4 * fq;
#pragma unroll
            for (int ai = 0; ai < 2; ++ai)
#pragma unroll
                for (int m = 0; m < 4; ++m) {
                    const int r = rbase + ai * 128 + m * 16;
#pragma unroll
                    for (int n = 0; n < 2; ++n) {
                        const f32x4 a = acc[ai][0][m][n], gt = acc[ai][1][m][n];
                        u32x2 w; w.x = cvt_pk_bf16(a[0] * sigmoidf_(gt[0]), a[1] * sigmoidf_(gt[1])); w.y = cvt_pk_bf16(a[2] * sigmoidf_(gt[2]), a[3] * sigmoidf_(gt[3]));
                        *(u32x2*)(U + (size_t)r * 512 + chb + n * 16) = w;
                    }
                }
        }
    }
};

template <bool FROMX> struct EpiResid {
    static constexpr bool PERM = false;
    const float* xp; const float* xs; float* Y; const float* gate;
    __device__ __forceinline__ void operator()(const f32x4 (&acc)[2][2][4][2], const Unit& u, int wr, int wc, int fr, int fq) const {
        const int mi = u.pm < 16 ? 0 : 1 + ((u.pm - 16) >> 3);
        const float* gp = gate + mi * 6144;
        const int rbase = u.pm * 256 + wr * 64 + fr;
#pragma unroll
        for (int bj = 0; bj < 2; ++bj)
#pragma unroll
            for (int n = 0; n < 2; ++n) {
                const int col = u.pn * 256 + bj * 128 + wc * 32 + n * 16 + 4 * fq;
                const f32x4 g4 = *(const f32x4*)(gp + col);
#pragma unroll
                for (int ai = 0; ai < 2; ++ai)
#pragma unroll
                    for (int m = 0; m < 4; ++m) {
                        const int r = rbase + ai * 128 + m * 16;
                        const float* bp = FROMX ? (u.pm < 16 ? xp + (size_t)r * 1024 : xs + (size_t)(r - MCTX) * 1024) : Y + (size_t)r * 1024;
                        const f32x4 b4 = *(const f32x4*)(bp + col);
                        *(f32x4*)(Y + (size_t)r * 1024 + col) = b4 + g4 * acc[ai][bj][m][n];
                    }
            }
    }
};

struct EpiSqRelu {
    static constexpr bool PERM = true;
    bf16_t* F;
    __device__ __forceinline__ void operator()(const f32x4 (&acc)[2][2][4][2], const Unit& u, int wr, int wc, int fr, int fq) const {
        const int rbase = u.pm * 256 + wr * 64 + fr, col0 = u.pn * 256 + wc * 32 + 8 * fq;
#pragma unroll
        for (int ai = 0; ai < 2; ++ai)
#pragma unroll
            for (int m = 0; m < 4; ++m) { bf16_t* rowp = F + (size_t)(rbase + ai * 128 + m * 16) * 4096 + col0;
#pragma unroll
                for (int bj = 0; bj < 2; ++bj) { f32x4 v0 = acc[ai][bj][m][0], v1 = acc[ai][bj][m][1];
#pragma unroll
                    for (int j = 0; j < 4; ++j) { const float a = fmaxf(v0[j], 0.f), b = fmaxf(v1[j], 0.f); v0[j] = a * a; v1[j] = b * b; }
                    u32x4 w; w.x = cvt_pk_bf16(v0[0], v0[1]); w.y = cvt_pk_bf16(v0[2], v0[3]); w.z = cvt_pk_bf16(v1[0], v1[1]); w.w = cvt_pk_bf16(v1[2], v1[3]);
                    *(u32x4*)(rowp + bj * 128) = w; } }
    }
};

__device__ __forceinline__ float gelu_tanh(float x) { const float u2 = 1.5957691216057308f * (x + 0.044715f * x * x * x); return x / (1.0f + __expf(-u2)); }

struct EpiLruIn {
    static constexpr bool PERM = true;
    bf16_t *G, *R;
    __device__ __forceinline__ void operator()(const f32x4 (&acc)[2][2][4][2], const Unit& u, int wr, int wc, int fr, int fq) const {
        const bool isg = u.pn < 4;
        bf16_t* O = isg ? G : R;
        const int rbase = u.pm * 256 + wr * 64 + fr, col0 = (u.pn & 3) * 256 + wc * 32 + 8 * fq;
#pragma unroll
        for (int ai = 0; ai < 2; ++ai)
#pragma unroll
            for (int m = 0; m < 4; ++m) { bf16_t* rowp = O + (size_t)(rbase + ai * 128 + m * 16) * 1024 + col0;
#pragma unroll
                for (int bj = 0; bj < 2; ++bj) { f32x4 v0 = acc[ai][bj][m][0], v1 = acc[ai][bj][m][1];
                    if (isg) {
#pragma unroll
                        for (int j = 0; j < 4; ++j) { v0[j] = gelu_tanh(v0[j]); v1[j] = gelu_tanh(v1[j]); } }
                    u32x4 w; w.x = cvt_pk_bf16(v0[0], v0[1]); w.y = cvt_pk_bf16(v0[2], v0[3]); w.z = cvt_pk_bf16(v1[0], v1[1]); w.w = cvt_pk_bf16(v1[2], v1[3]);
                    *(u32x4*)(rowp + bj * 128) = w; } }
    }
};

struct EpiGates {
    static constexpr bool PERM = false;
    const bf16_t* XC; unsigned* LB; const float *ba, *bx, *lam;
    __device__ __forceinline__ void operator()(const f32x4 (&acc)[2][2][4][2], const Unit& u, int wr, int wc, int fr, int fq) const {
        const int dir = u.pn & 1, grp = u.pn >> 1;
        const int rbase = u.pm * 256 + wr * 64 + fr;
#pragma unroll
        for (int n = 0; n < 2; ++n) {
            const int chb = grp * 128 + wc * 32 + n * 16 + 4 * fq;
            const f32x4 ba4 = *(const f32x4*)(ba + dir * 1024 + chb), bx4 = *(const f32x4*)(bx + dir * 1024 + chb), lm4 = *(const f32x4*)(lam + dir * 1024 + chb);
            float lu[4];
#pragma unroll
            for (int j = 0; j < 4; ++j) { const float e = __expf(-lm4[j]); lu[j] = -8.0f * e * (1.0f - e * (0.5f - e * (0.33333333f - e * 0.25f))); }
#pragma unroll
            for (int ai = 0; ai < 2; ++ai)
#pragma unroll
                for (int m = 0; m < 4; ++m) {
                    const int r = rbase + ai * 128 + m * 16;
                    const u32x2 xw = *(const u32x2*)(XC + (size_t)r * 1024 + chb);
                    const float xc[4] = {bflo(xw.x), bfhi(xw.x), bflo(xw.y), bfhi(xw.y)};
                    const f32x4 pr = acc[ai][0][m][n] + ba4, pi = acc[ai][1][m][n] + bx4;
                    u32x4 w;
#pragma unroll
                    for (int j = 0; j < 4; ++j) { const float rr = sigmoidf_(pr[j]), ii = sigmoidf_(pi[j]); const float la = rr * lu[j];
                        const float a2 = __expf(2.0f * la); const float bb = sqrtf(fmaxf(1.0f - a2, 0.f)) * ii * xc[j]; w[j] = cvt_pk_bf16(la, bb); }
                    *(u32x4*)(LB + ((size_t)dir * MT + r) * 1024 + chb) = w;
                    asm volatile("" ::: "memory");
                }
        }
    }
};

struct TJob { const float* src; bf16_t* dst; int K, N, ldd, kind; };
constexpr int N_ADA = 192, N_TR = 5696, N_CACHE = 32;

__device__ __forceinline__ void phase_prep(const Params& p, LAS unsigned char* lds) {
    const int tid = threadIdx.x;
    unsigned char* ws = p.ws;
    for (int it = blockIdx.x; it < N_ADA + N_TR + N_CACHE; it += gridDim.x) {
        if (it < N_ADA) {
            const int l = it / 96, n0 = (it % 96) * 64;
            LAS float* sc = (LAS float*)lds;
            LAS float* red = (LAS float*)(lds + 20480);
            for (int i = tid; i < 5120; i += 512) { const int j = i >> 10, k = i & 1023; const float x = (j == 0) ? p.in[6][k] : p.in[2][(j - 1) * 1024 + k]; sc[i] = x / (1.0f + __expf(-x)); }
            __syncthreads();
            const int col = tid & 63, kg = tid >> 6;
            const float* w = p.in[7] + (size_t)l * 1024 * 6144 + (size_t)(kg * 128) * 6144 + n0 + col;
            float a0 = 0.f, a1 = 0.f, a2 = 0.f, a3 = 0.f, a4 = 0.f;
#pragma unroll 8
            for (int k = 0; k < 128; ++k) { const float wv = w[(size_t)k * 6144]; const int kk = kg * 128 + k;
                a0 += sc[kk] * wv; a1 += sc[1024 + kk] * wv; a2 += sc[2048 + kk] * wv; a3 += sc[3072 + kk] * wv; a4 += sc[4096 + kk] * wv; }
            red[(kg * 5 + 0) * 64 + col] = a0; red[(kg * 5 + 1) * 64 + col] = a1; red[(kg * 5 + 2) * 64 + col] = a2; red[(kg * 5 + 3) * 64 + col] = a3; red[(kg * 5 + 4) * 64 + col] = a4;
            __syncthreads();
            if (tid < 320) { const int j = tid >> 6; float s = 0.f;
#pragma unroll
                for (int g = 0; g < 8; ++g) s += red[(g * 5 + j) * 64 + col];
                ((float*)(ws + WS_MOD))[(l * 5 + j) * 6144 + n0 + col] = s + p.in[8][l * 6144 + n0 + col]; }
            __syncthreads();
        } else if (it < N_ADA + N_TR) {
            int t = it - N_ADA; TJob j;
            if (t < 448) { j = {p.in[13], (bf16_t*)(ws + WS_WATTIN), 1024, 1792, 1024, 1}; }
            else if ((t -= 448) < 256) { j = {p.in[14], (bf16_t*)(ws + WS_WATTOUT), 1024, 1024, 1024, 0}; }
            else if ((t -= 256) < 2048) { const int l = t >> 10; t &= 1023; j = {p.in[11] + (size_t)l * 1024 * 4096, (bf16_t*)(ws + WS_WFF1) + (size_t)l * 4096 * 1024, 1024, 4096, 1024, 0}; }
            else if ((t -= 2048) < 2048) { const int l = t >> 10; t &= 1023; j = {p.in[12] + (size_t)l * 4096 * 1024, (bf16_t*)(ws + WS_WFF2) + (size_t)l * 1024 * 4096, 4096, 1024, 4096, 0}; }
            else if ((t -= 2048) < 512) { j = {p.in[20], (bf16_t*)(ws + WS_WLRUIN), 1024, 2048, 1024, 0}; }
            else if ((t -= 512) < 256) { j = {p.in[21], (bf16_t*)(ws + WS_WLRUOUT), 1024, 1024, 1024, 0}; }
            else { t -= 256; const int mtx = t >> 2; t &= 3; const int which = mtx >> 4, dir = (mtx >> 3) & 1, blk = mtx & 7;
                j = {(which ? p.in[26] : p.in[24]) + (size_t)(dir * 8 + blk) * 16384, (bf16_t*)(ws + WS_WG) + (size_t)(blk * 512 + dir * 256 + which * 128) * 128, 128, 128, 128, 0}; }
            const int nn = j.N >> 6, k0 = (t / nn) * 64, n0 = (t % nn) * 64;
            LAS bf16_t* tile = (LAS bf16_t*)lds;
#pragma unroll
            for (int ps = 0; ps < 2; ++ps) { const int kk = (tid >> 4) + 32 * ps, n4 = tid & 15;
                const f32x4 v = *(const f32x4*)(j.src + (size_t)(k0 + kk) * j.N + n0 + 4 * n4);
#pragma unroll
                for (int e = 0; e < 4; ++e) tile[(4 * n4 + e) * 72 + kk] = (bf16_t)(cvt_pk_bf16(v[e], 0.f) & 0xffffu); }
            __syncthreads();
            { const int nl = tid >> 3, k8 = tid & 7; int n = n0 + nl;
              if (j.kind == 1 && n >= 768) { const int np = n - 768, sel = np >> 9, chn = np & 511; n = 768 + (chn >> 7) * 256 + sel * 128 + (chn & 127); }
              const u32x4 v = *(const LAS u32x4*)(lds + nl * 144 + k8 * 16);
              *(u32x4*)(j.dst + (size_t)n * j.ldd + k0 + 8 * k8) = v; }
            __syncthreads();
        } else {
            const int ci = it - N_ADA - N_TR;
            bf16_t* cK = (bf16_t*)(ws + WS_CK); bf16_t* cVt = (bf16_t*)(ws + WS_CVT);
            for (int e = tid; e < 4096; e += 512) { const int o = ci * 4096 + e;
                { const int d = o & 63, t = (o >> 6) & 255, kvh = (o >> 14) & 1, b = o >> 15; cK[o] = (bf16_t)(cvt_pk_bf16(p.in[3][((size_t)(b * 256 + t) * 2 + kvh) * 64 + d], 0.f) & 0xffffu); }
                { const int t = o & 255, d = (o >> 8) & 63, kvh = (o >> 14) & 1, b = o >> 15; cVt[o] = (bf16_t)(cvt_pk_bf16(p.in[4][((size_t)(b * 256 + t) * 2 + kvh) * 64 + d], 0.f) & 0xffffu); } }
        }
    }
}

template <int MODE>
__device__ __forceinline__ void phase_norm(const Params& p, const float* gvec, const float* modl, int ch_shift, int ch_scale) {
    const int lane = threadIdx.x & 63, wid = threadIdx.x >> 6;
    bf16_t* HA = (bf16_t*)(p.ws + WS_HA);
    for (int row = blockIdx.x * 8 + wid; row < MT; row += gridDim.x * 8) {
        const float* src = (MODE == 0) ? (row < MCTX ? p.in[0] + (size_t)row * 1024 : p.in[1] + (size_t)(row - MCTX) * 1024) : p.out + (size_t)row * 1024;
        f32x4 v[4]; float ss = 0.f;
#pragma unroll
        for (int i = 0; i < 4; ++i) { v[i] = *(const f32x4*)(src + i * 256 + lane * 4); ss += v[i][0] * v[i][0] + v[i][1] * v[i][1] + v[i][2] * v[i][2] + v[i][3] * v[i][3]; }
#pragma unroll
        for (int o = 32; o >= 1; o >>= 1) ss += __shfl_xor(ss, o);
        const float rstd = rsqrtf(ss * (1.0f / 1024.0f) + 1e-6f);
        const int mi = row < MCTX ? 0 : 1 + ((row - MCTX) >> 11);
#pragma unroll
        for (int i = 0; i < 4; ++i) { const int c = i * 256 + lane * 4; const f32x4 g4 = *(const f32x4*)(gvec + c);
            f32x4 o = v[i] * rstd * g4;
            if (MODE < 2) { const f32x4 sc = *(const f32x4*)(modl + mi * 6144 + ch_scale * 1024 + c), sh = *(const f32x4*)(modl + mi * 6144 + ch_shift * 1024 + c);
                o = o * (sc + 1.0f) + sh;
                u32x2 w; w.x = cvt_pk_bf16(o[0], o[1]); w.y = cvt_pk_bf16(o[2], o[3]); *(u32x2*)(HA + (size_t)row * 1024 + c) = w; }
            else *(f32x4*)(p.out + (size_t)row * 1024 + c) = o; }
    }
}

constexpr int SV_OFF = 128 * 144;
__device__ __forceinline__ void attn_item(const Params& p, LAS unsigned char* lds, int it) {
    const int tid = threadIdx.x, lane = tid & 63, wid = tid >> 6, fr = lane & 15, fq = lane >> 4;
    unsigned char* ws = p.ws;
    const bf16_t* Q = (const bf16_t*)(ws + WS_Q); const bf16_t* Kb = (const bf16_t*)(ws + WS_KB);
    const bf16_t* VtL = (const bf16_t*)(ws + WS_VTL); const bf16_t* VtC = (const bf16_t*)(ws + WS_VTC);
    const bf16_t* cK = (const bf16_t*)(ws + WS_CK); const bf16_t* cVt = (const bf16_t*)(ws + WS_CVT);
    bf16_t* MIX = (bf16_t*)(ws + WS_MIX);
    const bool lat = it < 128;
    int b, kvh, n = 0, row0;
    if (lat) { b = it >> 5; kvh = (it >> 4) & 1; n = it & 15; row0 = MCTX + b * 2048 + n * 128; }
    else { const int i2 = it - 128; b = i2 >> 2; kvh = (i2 >> 1) & 1; row0 = b * 256 + (i2 & 1) * 128; }
    const int g = wid >> 1, qoff = (wid & 1) * 64, h = kvh * 4 + g;
    bf16x8 qreg[4][2];
#pragma unroll
    for (int qs = 0; qs < 4; ++qs)
#pragma unroll
        for (int dh = 0; dh < 2; ++dh) qreg[qs][dh] = *(const bf16x8*)(Q + (size_t)(row0 + qoff + qs * 16 + fr) * 512 + h * 64 + dh * 32 + fq * 8);
    const float sink = p.in[15][h];
    float m_[4], l_[4]; f32x4 o[4][4];
#pragma unroll
    for (int qs = 0; qs < 4; ++qs) { m_[qs] = sink; l_[qs] = (fq == 0) ? 1.0f : 0.0f;
#pragma unroll
        for (int ds = 0; ds < 4; ++ds) o[qs][ds] = (f32x4){0.f, 0.f, 0.f, 0.f}; }
    const int nch = lat ? 5 : 2;
    for (int c = 0; c < nch; ++c) {
        const bf16_t* kp; const bf16_t* vp; int kpitch, vpitch, mtype = 0;
        if (lat) {
            if (c < 3) { const int cb = n - 1 + c; if (cb < 0 || cb > 15) continue;
                kp = Kb + (size_t)(MCTX + b * 2048 + cb * 128) * 128 + kvh * 64; kpitch = 128; vp = VtL + (size_t)((b * 2 + kvh) * 64) * 2048 + cb * 128; vpitch = 2048; mtype = (c == 0) ? 1 : (c == 2 ? 2 : 0); }
            else { const int cc = c - 3; kp = cK + (size_t)((b * 2 + kvh) * 256 + cc * 128) * 64; kpitch = 64; vp = cVt + (size_t)((b * 2 + kvh) * 64) * 256 + cc * 128; vpitch = 256; }
        } else { kp = Kb + (size_t)(b * 256 + c * 128) * 128 + kvh * 64; kpitch = 128; vp = VtC + (size_t)((b * 2 + kvh) * 64) * 256 + c * 128; vpitch = 256; }
        __syncthreads();
#pragma unroll
        for (int e = 0; e < 2; ++e) { const int pc = tid + e * 512; const int key = pc >> 3, d8 = pc & 7;
            const u32x4 v = *(const u32x4*)(kp + (size_t)key * kpitch + d8 * 8); *(LAS u32x4*)(lds + key * 144 + d8 * 16) = v; }
#pragma unroll
        for (int e = 0; e < 2; ++e) { const int pc = tid + e * 512; const int d = pc >> 4, k8 = pc & 15;
            const u32x4 v = *(const u32x4*)(vp + (size_t)d * vpitch + k8 * 8); *(LAS u32x4*)(lds + SV_OFF + d * 272 + k8 * 16) = v; }
        __syncthreads();
#pragma unroll 1
        for (int ks = 0; ks < 4; ++ks) {
            bf16x8 kreg[2][2], vreg[4];
#pragma unroll
            for (int kt = 0; kt < 2; ++kt)
#pragma unroll
                for (int dh = 0; dh < 2; ++dh) kreg[kt][dh] = *(const LAS bf16x8*)(lds + (ks * 32 + kt * 16 + fr) * 144 + (dh * 32 + fq * 8) * 2);
#pragma unroll
            for (int ds = 0; ds < 4; ++ds) { const u32x2 lo = *(const LAS u32x2*)(lds + SV_OFF + (ds * 16 + fr) * 272 + (ks * 32 + 4 * fq) * 2);
                const u32x2 hi = *(const LAS u32x2*)(lds + SV_OFF + (ds * 16 + fr) * 272 + (ks * 32 + 16 + 4 * fq) * 2);
                const u32x4 vv = {lo.x, lo.y, hi.x, hi.y}; vreg[ds] = __builtin_bit_cast(bf16x8, vv); }
#pragma unroll
            for (int qs = 0; qs < 4; ++qs) {
                f32x4 s0 = {0.f, 0.f, 0.f, 0.f}, s1 = {0.f, 0.f, 0.f, 0.f};
                s0 = __builtin_amdgcn_mfma_f32_16x16x32_bf16(kreg[0][0], qreg[qs][0], s0, 0, 0, 0); s0 = __builtin_amdgcn_mfma_f32_16x16x32_bf16(kreg[0][1], qreg[qs][1], s0, 0, 0, 0);
                s1 = __builtin_amdgcn_mfma_f32_16x16x32_bf16(kreg[1][0], qreg[qs][0], s1, 0, 0, 0); s1 = __builtin_amdgcn_mfma_f32_16x16x32_bf16(kreg[1][1], qreg[qs][1], s1, 0, 0, 0);
                if (mtype) { const int ii = qoff + qs * 16 + fr;
#pragma unroll
                    for (int j = 0; j < 4; ++j) { const int j0 = ks * 32 + 4 * fq + j, j1 = j0 + 16;
                        const bool v0 = (mtype == 1) ? (j0 >= ii) : (j0 <= ii), v1 = (mtype == 1) ? (j1 >= ii) : (j1 <= ii);
                        if (!v0) s0[j] = -1e30f; if (!v1) s1[j] = -1e30f; } }
                float mx = fmaxf(fmaxf(fmaxf(s0[0], s0[1]), fmaxf(s0[2], s0[3])), fmaxf(fmaxf(s1[0], s1[1]), fmaxf(s1[2], s1[3])));
                mx = fmaxf(mx, __shfl_xor(mx, 16)); mx = fmaxf(mx, __shfl_xor(mx, 32));
                const float mn = fmaxf(m_[qs], mx), alpha = __expf(m_[qs] - mn); m_[qs] = mn;
                float ps = 0.f;
#pragma unroll
                for (int j = 0; j < 4; ++j) { s0[j] = __expf(s0[j] - mn); s1[j] = __expf(s1[j] - mn); ps += s0[j] + s1[j]; }
                l_[qs] = l_[qs] * alpha + ps;
                const u32x4 pw = {cvt_pk_bf16(s0[0], s0[1]), cvt_pk_bf16(s0[2], s0[3]), cvt_pk_bf16(s1[0], s1[1]), cvt_pk_bf16(s1[2], s1[3])};
                const bf16x8 pb = __builtin_bit_cast(bf16x8, pw);
#pragma unroll
                for (int ds = 0; ds < 4; ++ds) { o[qs][ds] = o[qs][ds] * alpha; o[qs][ds] = __builtin_amdgcn_mfma_f32_16x16x32_bf16(vreg[ds], pb, o[qs][ds], 0, 0, 0); }
            }
        }
    }
#pragma unroll
    for (int qs = 0; qs < 4; ++qs) { float lt = l_[qs]; lt += __shfl_xor(lt, 16); lt += __shfl_xor(lt, 32); const float inv = 1.0f / lt;
        bf16_t* dst = MIX + (size_t)(row0 + qoff + qs * 16 + fr) * 1024 + h * 64 + 4 * fq;
#pragma unroll
        for (int ds = 0; ds < 4; ++ds) { const f32x4 v = o[qs][ds] * inv; u32x2 w; w.x = cvt_pk_bf16(v[0], v[1]); w.y = cvt_pk_bf16(v[2], v[3]); *(u32x2*)(dst + ds * 16) = w; } }
}

__device__ __forceinline__ void conv_item(const Params& p, LAS unsigned char* lds, int ci) {
    const int tid = threadIdx.x, lane = tid & 63, wid = tid >> 6;
    const bf16_t* U = (const bf16_t*)(p.ws + WS_U); bf16_t* MIX = (bf16_t*)(p.ws + WS_MIX);
    const int row0 = ci * 32;
    int s0, s1; if (row0 < MCTX) { s0 = row0 & ~255; s1 = s0 + 256; } else { s0 = MCTX + ((row0 - MCTX) & ~2047); s1 = s0 + 2048; }
    __syncthreads();
    for (int pc = tid; pc < 62 * 64; pc += 512) { const int rr = pc >> 6, c8 = pc & 63, grow = row0 - 15 + rr; u32x4 v = {0u, 0u, 0u, 0u};
        if (grow >= s0 && grow < s1) v = *(const u32x4*)(U + (size_t)grow * 512 + c8 * 8);
        *(LAS u32x4*)(lds + rr * 1024 + c8 * 16) = v; }
    __syncthreads();
    const int cp = tid & 255, th = tid >> 8;
    float w0[31], w1[31];
#pragma unroll
    for (int k = 0; k < 31; ++k) { const f32x2 wv = *(const f32x2*)(p.in[16] + k * 512 + 2 * cp); w0[k] = wv.x; w1[k] = wv.y; }
    const f32x2 bv = *(const f32x2*)(p.in[17] + 2 * cp);
    LAS f32x2* zb = (LAS f32x2*)(lds + 65536);
#pragma unroll 1
    for (int tt = 0; tt < 16; ++tt) { const int t = th * 16 + tt; float a0 = bv.x, a1 = bv.y;
#pragma unroll
        for (int k = 0; k < 31; ++k) { const unsigned x = *(const LAS unsigned*)(lds + (t + k) * 1024 + cp * 4); a0 += w0[k] * bflo(x); a1 += w1[k] * bfhi(x); }
        zb[t * 256 + cp] = (f32x2){a0, a1}; }
    __syncthreads();
    const f32x4 g0 = *(const f32x4*)(p.in[18] + lane * 8), g1 = *(const f32x4*)(p.in[18] + lane * 8 + 4), be0 = *(const f32x4*)(p.in[19] + lane * 8), be1 = *(const f32x4*)(p.in[19] + lane * 8 + 4);
#pragma unroll 1
    for (int q = 0; q < 4; ++q) { const int t = wid * 4 + q;
        const LAS float* zr = (const LAS float*)(lds + 65536 + t * 2048);
        f32x4 v0 = *(const LAS f32x4*)(zr + lane * 8), v1 = *(const LAS f32x4*)(zr + lane * 8 + 4);
        float s = (v0[0] + v0[1]) + (v0[2] + v0[3]) + (v1[0] + v1[1]) + (v1[2] + v1[3]);
#pragma unroll
        for (int o = 32; o >= 1; o >>= 1) s += __shfl_xor(s, o);
        const float mean = s * (1.0f / 512.0f);
        v0 = v0 - mean; v1 = v1 - mean;
        float qv = (v0[0] * v0[0] + v0[1] * v0[1]) + (v0[2] * v0[2] + v0[3] * v0[3]) + (v1[0] * v1[0] + v1[1] * v1[1]) + (v1[2] * v1[2] + v1[3] * v1[3]);
#pragma unroll
        for (int o = 32; o >= 1; o >>= 1) qv += __shfl_xor(qv, o);
        const float rstd = rsqrtf(qv * (1.0f / 512.0f) + 1e-6f);
        v0 = v0 * rstd * g0 + be0; v1 = v1 * rstd * g1 + be1;
#pragma unroll
        for (int j = 0; j < 4; ++j) { v0[j] = v0[j] * sigmoidf_(v0[j]); v1[j] = v1[j] * sigmoidf_(v1[j]); }
        u32x4 w; w.x = cvt_pk_bf16(v0[0], v0[1]); w.y = cvt_pk_bf16(v0[2], v0[3]); w.z = cvt_pk_bf16(v1[0], v1[1]); w.w = cvt_pk_bf16(v1[2], v1[3]);
        *(u32x4*)(MIX + (size_t)(row0 + t) * 1024 + 512 + lane * 8) = w; }
}

__device__ __forceinline__ void phase_conv4(const Params& p) {
    const bf16_t* R = (const bf16_t*)(p.ws + WS_R); bf16_t* XC = (bf16_t*)(p.ws + WS_HA);
    for (int idx = blockIdx.x * 512 + threadIdx.x; idx < MT * 128; idx += gridDim.x * 512) {
        const int row = idx >> 7, c8 = idx & 127;
        int s0, s1; if (row < MCTX) { s0 = row & ~255; s1 = s0 + 256; } else { s0 = MCTX + ((row - MCTX) & ~2047); s1 = s0 + 2048; }
        f32x4 a0 = *(const f32x4*)(p.in[23] + c8 * 8), a1 = *(const f32x4*)(p.in[23] + c8 * 8 + 4);
#pragma unroll
        for (int k = 0; k < 4; ++k) { const int rr = row + k - 1;
            if (rr >= s0 && rr < s1) { const u32x4 x = *(const u32x4*)(R + (size_t)rr * 1024 + c8 * 8);
                const f32x4 w0 = *(const f32x4*)(p.in[22] + k * 1024 + c8 * 8), w1 = *(const f32x4*)(p.in[22] + k * 1024 + c8 * 8 + 4);
                a0[0] += w0[0] * bflo(x.x); a0[1] += w0[1] * bfhi(x.x); a0[2] += w0[2] * bflo(x.y); a0[3] += w0[3] * bfhi(x.y);
                a1[0] += w1[0] * bflo(x.z); a1[1] += w1[1] * bfhi(x.z); a1[2] += w1[2] * bflo(x.w); a1[3] += w1[3] * bfhi(x.w); } }
        u32x4 w; w.x = cvt_pk_bf16(a0[0], a0[1]); w.y = cvt_pk_bf16(a0[2], a0[3]); w.z = cvt_pk_bf16(a1[0], a1[1]); w.w = cvt_pk_bf16(a1[2], a1[3]);
        *(u32x4*)(XC + (size_t)row * 1024 + c8 * 8) = w;
    }
}

constexpr int CH = 64, NCHUNK = MT / CH;
__device__ __forceinline__ void phase_scan_sum(const Params& p) {
    const unsigned* LB = (const unsigned*)(p.ws + WS_LB); float* SUM = (float*)(p.ws + WS_SUM);
    const int cp = threadIdx.x;
    for (int bi = blockIdx.x; bi < NCHUNK * 2; bi += gridDim.x) {
        const int c = bi >> 1, dir = bi & 1;
        const unsigned* base = LB + ((size_t)dir * MT + (size_t)c * CH) * 1024 + 2 * cp;
        float A0 = 1.f, A1 = 1.f, B0 = 0.f, B1 = 0.f;
#pragma unroll 8
        for (int i = 0; i < CH; ++i) { const int t = dir ? (CH - 1 - i) : i; const u32x2 w = *(const u32x2*)(base + (size_t)t * 1024);
            const float a0 = __expf(bflo(w.x)), a1 = __expf(bflo(w.y)); B0 = a0 * B0 + bfhi(w.x); B1 = a1 * B1 + bfhi(w.y); A0 *= a0; A1 *= a1; }
        *(f32x4*)(SUM + ((size_t)(c * 2 + dir) * 1024 + 2 * cp) * 2) = (f32x4){A0, B0, A1, B1};
    }
}

__device__ __forceinline__ void phase_scan_final(const Params& p) {
    unsigned* LB = (unsigned*)(p.ws + WS_LB); const float* SUM = (const float*)(p.ws + WS_SUM);
    const unsigned* G = (const unsigned*)(p.ws + WS_G); unsigned* YA = (unsigned*)(p.ws + WS_R);
    float* outh = p.out + 13631488;
    const int cp = threadIdx.x;
    for (int c = blockIdx.x; c < NCHUNK; c += gridDim.x) {
        const int row0 = c * CH; const bool ctx = row0 < MCTX;
        int cs0, ncs, b; if (ctx) { b = row0 >> 8; cs0 = b * 4; ncs = 4; } else { b = (row0 - MCTX) >> 11; cs0 = 64 + b * 32; ncs = 32; }
        float hf0 = 0.f, hf1 = 0.f, hb0 = 0.f, hb1 = 0.f;
        if (!ctx) { const f32x2 f = *(const f32x2*)(p.in[5] + (size_t)(b * 2 + 0) * 1024 + 2 * cp), bk = *(const f32x2*)(p.in[5] + (size_t)(b * 2 + 1) * 1024 + 2 * cp); hf0 = f.x; hf1 = f.y; hb0 = bk.x; hb1 = bk.y; }
        for (int cc = cs0; cc < c; ++cc) { const f32x4 s = *(const f32x4*)(SUM + ((size_t)(cc * 2 + 0) * 1024 + 2 * cp) * 2); hf0 = s[0] * hf0 + s[1]; hf1 = s[2] * hf1 + s[3]; }
        for (int cc = cs0 + ncs - 1; cc > c; --cc) { const f32x4 s = *(const f32x4*)(SUM + ((size_t)(cc * 2 + 1) * 1024 + 2 * cp) * 2); hb0 = s[0] * hb0 + s[1]; hb1 = s[2] * hb1 + s[3]; }
        unsigned* lf = LB + ((size_t)row0) * 1024 + 2 * cp;
        const unsigned* lb = LB + ((size_t)MT + row0) * 1024 + 2 * cp;
#pragma unroll 8
        for (int t = 0; t < CH; ++t) { const u32x2 w = *(const u32x2*)(lf + (size_t)t * 1024);
            hf0 = __expf(bflo(w.x)) * hf0 + bfhi(w.x); hf1 = __expf(bflo(w.y)) * hf1 + bfhi(w.y);
            *(f32x2*)(lf + (size_t)t * 1024) = (f32x2){hf0, hf1}; }
        if (ctx && c == cs0 + ncs - 1) *(f32x2*)(outh + (size_t)(b * 2 + 0) * 1024 + 2 * cp) = (f32x2){hf0, hf1};
#pragma unroll 8
        for (int t = CH - 1; t >= 0; --t) { const u32x2 w = *(const u32x2*)(lb + (size_t)t * 1024);
            hb0 = __expf(bflo(w.x)) * hb0 + bfhi(w.x); hb1 = __expf(bflo(w.y)) * hb1 + bfhi(w.y);
            const f32x2 hf = *(const f32x2*)(lf + (size_t)t * 1024); const unsigned gw = G[(size_t)(row0 + t) * 512 + cp];
            YA[(size_t)(row0 + t) * 512 + cp] = cvt_pk_bf16((hf.x + hb0) * bflo(gw), (hf.y + hb1) * bfhi(gw)); }
        if (ctx && c == cs0) *(f32x2*)(outh + (size_t)(b * 2 + 1) * 1024 + 2 * cp) = (f32x2){hb0, hb1};
    }
}

__global__ void __launch_bounds__(512, 2) mega(Params p) {
    extern __shared__ __attribute__((aligned(16))) unsigned char lds_raw[];
    LAS unsigned char* lds = (LAS unsigned char*)lds_raw;
    cg::grid_group grid = cg::this_grid();
    if (threadIdx.x == 0) { *(volatile LAS unsigned*)(lds + 131072) = 0u; *(volatile LAS unsigned*)(lds + 131076) = 0u; }
    __syncthreads();
    XcdBarrier xbar = xcd_barrier_post((unsigned*)(p.ws + WS_BAR), (volatile LAS unsigned*)(lds + 131072));
    if (p.ph_hi > NPH) grid.sync();
    unsigned char* ws = p.ws;
    const float* mod0 = (const float*)(ws + WS_MOD); const float* mod1 = mod0 + 5 * 6144;
    bf16_t* HA = (bf16_t*)(ws + WS_HA);
    const int G_ = gridDim.x, bx = blockIdx.x;
#ifndef REP_MASK
#define REP_MASK 0u
#endif
#define NREP(k) (1 + (int)((REP_MASK >> (k)) & 1u))
#define PH_BEGIN(k) if (p.ph_lo <= (k) && (k) < p.ph_hi) { for (int rep_ = 0; rep_ < NREP(k); ++rep_) {
#define PH_END(k) if (rep_ + 1 < NREP(k) || (k) + 1 < p.ph_hi) xcd_barrier(xbar); } }
    PH_BEGIN(0) phase_prep(p, lds); PH_END(0)
    PH_BEGIN(1) phase_norm<0>(p, p.in[9], mod0, 0, 1); PH_END(1)
    PH_BEGIN(2) { pg8::Gemm g{HA, (const bf16_t*)(ws + WS_WATTIN), MT, 1792, 1024, 1024, 1024, 30, 0}; pg8::StaticOrder S; S.init(MT, 1792, G_, bx);
                  EpiQKVU E{(bf16_t*)(ws + WS_Q), (bf16_t*)(ws + WS_KB), (bf16_t*)(ws + WS_VTL), (bf16_t*)(ws + WS_VTC), (bf16_t*)(ws + WS_U), p.out + 12582912, p.out + 13107200};
                  pg8::gemm_phase(lds, g, S, E); } PH_END(2)
    PH_BEGIN(3) { int it = bx; for (; it < 192; it += G_) attn_item(p, lds, it); for (; it < 192 + 384; it += G_) conv_item(p, lds, it - 192); } PH_END(3)
    PH_BEGIN(4) { pg8::Gemm g{(const bf16_t*)(ws + WS_MIX), (const bf16_t*)(ws + WS_WATTOUT), MT, 1024, 1024, 1024, 1024, 30, 0}; pg8::StaticOrder S; S.init(MT, 1024, G_, bx);
                  EpiResid<true> E{p.in[0], p.in[1], p.out, mod0 + 2 * 1024}; pg8::gemm_phase(lds, g, S, E); } PH_END(4)
    PH_BEGIN(5) phase_norm<1>(p, p.in[10], mod0, 3, 4); PH_END(5)
    PH_BEGIN(6) { pg8::Gemm g{HA, (const bf16_t*)(ws + WS_WFF1), MT, 4096, 1024, 1024, 1024, 30, 0}; pg8::StaticOrder S; S.init(MT, 4096, G_, bx);
                  EpiSqRelu E{(bf16_t*)(ws + WS_F)}; pg8::gemm_phase(lds, g, S, E); } PH_END(6)
    PH_BEGIN(7) { pg8::Gemm g{(const bf16_t*)(ws + WS_F), (const bf16_t*)(ws + WS_WFF2), MT, 1024, 4096, 4096, 4096, 30, 0}; pg8::StaticOrder S; S.init(MT, 1024, G_, bx);
                  EpiResid<false> E{nullptr, nullptr, p.out, mod0 + 5 * 1024}; pg8::gemm_phase(lds, g, S, E); } PH_END(7)
    PH_BEGIN(8) phase_norm<1>(p, p.in[9] + 1024, mod1, 0, 1); PH_END(8)
    PH_BEGIN(9) { pg8::Gemm g{HA, (const bf16_t*)(ws + WS_WLRUIN), MT, 2048, 1024, 1024, 1024, 30, 0}; pg8::StaticOrder S; S.init(MT, 2048, G_, bx);
                  EpiLruIn E{(bf16_t*)(ws + WS_G), (bf16_t*)(ws + WS_R)}; pg8::gemm_phase(lds, g, S, E); } PH_END(9)
    PH_BEGIN(10) phase_conv4(p); PH_END(10)
    PH_BEGIN(11) { int k11 = 128; asm volatile("" : "+s"(k11));
                   pg8::Gemm g{HA, (const bf16_t*)(ws + WS_WG), MT, 4096, k11, 1024, 128, 1, 256}; pg8::StaticOrder S; S.init(MT, 4096, G_, bx);
                   EpiGates E{HA, (unsigned*)(ws + WS_LB), p.in[25], p.in[27], p.in[28]}; pg8::gemm_phase(lds, g, S, E); } PH_END(11)
    PH_BEGIN(12) phase_scan_sum(p); PH_END(12)
    PH_BEGIN(13) phase_scan_final(p); PH_END(13)
    PH_BEGIN(14) { pg8::Gemm g{(const bf16_t*)(ws + WS_R), (const bf16_t*)(ws + WS_WLRUOUT), MT, 1024, 1024, 1024, 1024, 30, 0}; pg8::StaticOrder S; S.init(MT, 1024, G_, bx);
                   EpiResid<false> E{nullptr, nullptr, p.out, mod1 + 2 * 1024}; pg8::gemm_phase(lds, g, S, E); } PH_END(14)
    PH_BEGIN(15) phase_norm<1>(p, p.in[10] + 1024, mod1, 3, 4); PH_END(15)
    PH_BEGIN(16) { pg8::Gemm g{HA, (const bf16_t*)(ws + WS_WFF1) + (size_t)4096 * 1024, MT, 4096, 1024, 1024, 1024, 30, 0}; pg8::StaticOrder S; S.init(MT, 4096, G_, bx);
                   EpiSqRelu E{(bf16_t*)(ws + WS_F)}; pg8::gemm_phase(lds, g, S, E); } PH_END(16)
    PH_BEGIN(17) { pg8::Gemm g{(const bf16_t*)(ws + WS_F), (const bf16_t*)(ws + WS_WFF2) + (size_t)1024 * 4096, MT, 1024, 4096, 4096, 4096, 30, 0}; pg8::StaticOrder S; S.init(MT, 1024, G_, bx);
                   EpiResid<false> E{nullptr, nullptr, p.out, mod1 + 5 * 1024}; pg8::gemm_phase(lds, g, S, E); } PH_END(17)
    PH_BEGIN(18) phase_norm<2>(p, p.in[29], mod0, 0, 0); PH_END(18)
}

extern "C" void kernel_launch(void* const* d_in, const int* in_sizes, int n_in, void* d_out, int out_size, void* d_ws, size_t ws_size, hipStream_t stream) {
    static int grid = 0;
    if (grid == 0) {
        if (n_in != 30 || out_size != 13664256 || ws_size < WS_END) { fprintf(stderr, "kernel_launch: unexpected problem (n_in %d out %d ws %zu)\n", n_in, out_size, ws_size); grid = -1; return; }
        int dev = 0, cus = 0, per_cu = 0;
        if (hipGetDevice(&dev) != hipSuccess || hipDeviceGetAttribute(&cus, hipDeviceAttributeMultiprocessorCount, dev) != hipSuccess) { grid = -1; return; }
        if (hipFuncSetAttribute((const void*)mega, hipFuncAttributeMaxDynamicSharedMemorySize, LDS_BYTES) != hipSuccess) { fprintf(stderr, "kernel_launch: hipFuncSetAttribute failed\n"); grid = -1; return; }
        if (hipOccupancyMaxActiveBlocksPerMultiprocessor(&per_cu, (const void*)mega, 512, LDS_BYTES) != hipSuccess || per_cu < 1) { fprintf(stderr, "kernel_launch: occupancy query says %d blocks per CU\n", per_cu); grid = -1; return; }
        grid = cus;
    }
    if (grid < 0) return;
    if (hipMemsetAsync((char*)d_ws + WS_BAR, 0, XCD_BAR_WORDS * 4, stream) != hipSuccess) { fprintf(stderr, "kernel_launch: memset failed\n"); return; }
    Params p{};
    for (int i = 0; i < 30; ++i) p.in[i] = (const float*)d_in[i];
    p.out = (float*)d_out; p.ws = (unsigned char*)d_ws;
#if N_LAUNCH_MODE == 1
    p.ph_lo = 0; p.ph_hi = NPH;
    void* args[] = {&p};
    hipError_t e = hipLaunchCooperativeKernel((const void*)mega, dim3(grid), dim3(512), args, LDS_BYTES, stream);
    if (e != hipSuccess) fprintf(stderr, "cooperative launch failed: %s (grid %d)\n", hipGetErrorString(e), grid);
#else
    for (int ph = 0; ph < NPH; ++ph) { p.ph_lo = ph; p.ph_hi = ph + 1; hipLaunchKernelGGL(mega, dim3(grid), dim3(512), LDS_BYTES, stream, p); }
#endif
}
```

```cpp
#include <hip/hip_runtime.h>
#include <hip/hip_cooperative_groups.h>
#include <cstdio>
#include <cstdint>
namespace cg = cooperative_groups;

#ifndef N_LAUNCH_MODE
#define N_LAUNCH_MODE 1
#endif

#define LAS __attribute__((address_space(3)))
typedef unsigned short bf16_t;
typedef short bf16x8 __attribute__((ext_vector_type(8)));
typedef float f32x4 __attribute__((ext_vector_type(4)));
typedef float f32x2 __attribute__((ext_vector_type(2)));
typedef unsigned u32x4 __attribute__((ext_vector_type(4)));
typedef unsigned u32x2 __attribute__((ext_vector_type(2)));

constexpr int MT = 12288, MCTX = 4096, DM = 1024;
constexpr int NPH = 19;
constexpr size_t MiB = 1024 * 1024;
constexpr size_t WS_MOD = 0;
constexpr size_t WS_SUM = 256 * 1024;
constexpr size_t WS_CK = WS_SUM + 3 * MiB;
constexpr size_t WS_CVT = WS_CK + 256 * 1024;
constexpr size_t WS_WATTIN = 4 * MiB;
constexpr size_t WS_WATTOUT = WS_WATTIN + 3584 * 1024;
constexpr size_t WS_WFF1 = WS_WATTOUT + 2 * MiB;
constexpr size_t WS_WFF2 = WS_WFF1 + 16 * MiB;
constexpr size_t WS_WLRUIN = WS_WFF2 + 16 * MiB;
constexpr size_t WS_WLRUOUT = WS_WLRUIN + 4 * MiB;
constexpr size_t WS_WG = WS_WLRUOUT + 2 * MiB;
constexpr size_t WS_HA = 49 * MiB;
constexpr size_t WS_G = 73 * MiB;
constexpr size_t WS_R = 97 * MiB;
constexpr size_t WS_F = 121 * MiB;
constexpr size_t WS_END = 217 * MiB;
constexpr size_t WS_Q = WS_F;
constexpr size_t WS_KB = WS_F + 12 * MiB;
constexpr size_t WS_VTL = WS_F + 15 * MiB;
constexpr size_t WS_VTC = WS_F + 17 * MiB;
constexpr size_t WS_U = WS_F + 18 * MiB;
constexpr size_t WS_MIX = WS_F + 30 * MiB;
constexpr size_t WS_LB = WS_F;
static_assert(WS_WG + 1 * MiB <= WS_HA, "weights overflow");

constexpr int LDS_BYTES = 131072 + 64;
constexpr size_t WS_BAR = 245760;

struct Params {
    const float* in[30];
    float* out;
    unsigned char* ws;
    int ph_lo, ph_hi;
};

__device__ __forceinline__ unsigned cvt_pk_bf16(float lo, float hi) { unsigned r; asm volatile("v_cvt_pk_bf16_f32 %0, %1, %2" : "=v"(r) : "v"(lo), "v"(hi)); return r; }
__device__ __forceinline__ float bflo(unsigned w) { return __uint_as_float(w << 16); }
__device__ __forceinline__ float bfhi(unsigned w) { return __uint_as_float(w & 0xffff0000u); }
__device__ __forceinline__ float sigmoidf_(float x) { return 1.0f / (1.0f + __expf(-x)); }


#define XB_TMO      128
#define XB_XCNT(j)  (256  + 64 * (j))
#define XB_XSUB(j)  (1280 + 64 * (j))
#define XB_XGEN(j)  (2304 + 64 * (j))
#define XB_TOP      3328
#define XB_TOPGEN   3392
#define XCD_BAR_WORDS 3456
#define XB_SPIN_CAP (1u << 18)
__device__ __forceinline__ unsigned xb_ld(unsigned* p)              { return __hip_atomic_load(p, __ATOMIC_RELAXED, __HIP_MEMORY_SCOPE_AGENT); }
__device__ __forceinline__ unsigned xb_add(unsigned* p, unsigned v) { return __hip_atomic_fetch_add(p, v, __ATOMIC_RELAXED, __HIP_MEMORY_SCOPE_AGENT); }
__device__ __forceinline__ unsigned xb_xcc_id() { return (unsigned)__builtin_amdgcn_s_getreg((3 << 11) | 20) & 0xFu; }
#define XB_SPIN(cond, bar) do { unsigned _sp = 0; while (cond) { __builtin_amdgcn_s_sleep(1); \
    if ((++_sp & 255u) == 0u) { if (xb_ld(&(bar)[XB_TMO])) break; if (_sp > XB_SPIN_CAP) { atomicAdd(&(bar)[XB_TMO], 1u); break; } } } } while (0)
struct XcdBarrier { unsigned* bar; unsigned x; volatile LAS unsigned* st; };
__device__ __forceinline__ XcdBarrier xcd_barrier_post(unsigned* bar, volatile LAS unsigned* st) {
    XcdBarrier b; b.bar = bar; b.x = xb_xcc_id(); b.st = st;
    if (threadIdx.x == 0) (void)xb_add(&bar[XB_XCNT(b.x)], 1u);
    return b;
}
__device__ __forceinline__ void xcd_barrier_complete(unsigned* bar, unsigned x, unsigned& nloc, unsigned& nx) {
    const unsigned G = gridDim.x * gridDim.y * gridDim.z;
    unsigned sum, cnt, mine, sp = 0u;
    for (;;) {
        sum = 0u; cnt = 0u; mine = 0u;
#pragma unroll
        for (unsigned j = 0; j < 16; ++j) { const unsigned c = xb_ld(&bar[XB_XCNT(j)]); sum += c; cnt += (c > 0u) ? 1u : 0u; mine = (j == x) ? c : mine; }
        if (sum == G) break;
        __builtin_amdgcn_s_sleep(1);
        if ((++sp & 255u) == 0u) { if (xb_ld(&bar[XB_TMO])) break; if (sp > XB_SPIN_CAP) { atomicAdd(&bar[XB_TMO], 1u); break; } }
    }
    nloc = mine > 0u ? mine : 1u; nx = cnt > 0u ? cnt : 1u;
}
__device__ __forceinline__ void xcd_barrier(const XcdBarrier& b) {
    asm volatile("s_waitcnt vmcnt(0)" ::: "memory");
    __syncthreads();
    if (threadIdx.x == 0) {
        unsigned* bar = b.bar;
        __builtin_amdgcn_s_waitcnt(0);
        unsigned nloc = b.st[0], nx = b.st[1];
        if (nloc == 0u) { xcd_barrier_complete(bar, b.x, nloc, nx); b.st[0] = nloc; b.st[1] = nx; }
        const unsigned old = xb_add(&bar[XB_XSUB(b.x)], 1u);
        const unsigned gen = old / nloc;
        if (old + 1u == (gen + 1u) * nloc) {
            __builtin_amdgcn_fence(__ATOMIC_RELEASE, "agent");
            asm volatile("s_waitcnt vmcnt(0)" ::: "memory");
            const unsigned og = xb_add(&bar[XB_TOP], 1u);
            const unsigned tg = og / nx;
            if (og + 1u == (tg + 1u) * nx) xb_add(&bar[XB_TOPGEN], 1u);
            else XB_SPIN(xb_ld(&bar[XB_TOPGEN]) == tg, bar);
            __builtin_amdgcn_fence(__ATOMIC_ACQUIRE, "agent");
            xb_add(&bar[XB_XGEN(b.x)], 1u);
            asm volatile("s_waitcnt vmcnt(0)" ::: "memory");
        } else {
            XB_SPIN(xb_ld(&bar[XB_XGEN(b.x)]) == gen, bar);
            __builtin_amdgcn_fence(__ATOMIC_ACQUIRE, "agent");
            asm volatile("s_waitcnt vmcnt(0)" ::: "memory");
        }
    }
    __syncthreads();
}

namespace pg8 {
constexpr int BM = 256, BK = 64, HALF = 128, HTB = HALF * BK * 2, STAGE_BYTES = 8 * HTB, NXCD = 8, WGM = 8;
__host__ __device__ __forceinline__ int lds_byte(int r, int c) { const int st = (r >> 4) * 2 + (c >> 5), rr = r & 15, cc = c & 31, ob = rr * 64 + cc * 2; return st * 1024 + (ob ^ (((ob >> 9) & 1) << 5)); }
__host__ __device__ __forceinline__ void stage_rc(int b, int& R, int& C) { const int st = b / 1024, sb = b % 1024, swz = sb ^ (((sb >> 9) & 1) << 5); R = (st >> 1) * 16 + swz / 64; C = (st & 1) * 32 + (swz % 64) / 2; }
__host__ __device__ __forceinline__ int perm32(int rho) { const int n = rho >> 4, i = rho & 15; return 8 * (i >> 2) + 4 * n + (i & 3); }

struct Unit { int pm, pn; };
struct Gemm { const bf16_t* A; const bf16_t* Bt; int M, N, K, lda, ldb, gshift, goff; };

struct StaticOrder {
    int nM, nN, nwg, G, c;
    __host__ __device__ void init(int M, int N, int G_, int c_) { nM = M / BM; nN = N / BM; nwg = nM * nN; G = G_; c = c_; }
    __host__ __device__ bool next(int i, Unit& u) const {
        const long L = (long)i * G + c; if (L >= nwg) return false;
        int wgid = (int)L; { const int q = nwg / NXCD, r = nwg % NXCD, xcd = wgid % NXCD, off = wgid / NXCD; wgid = (xcd < r ? xcd * (q + 1) : r * (q + 1) + (xcd - r) * q) + off; }
        const int nig = WGM * nN, gid = wgid / nig, fm = gid * WGM, gsz = (nM - fm) < WGM ? (nM - fm) : WGM;
        u.pm = fm + ((wgid % nig) % gsz); u.pn = (wgid % nig) / gsz; return true;
    }
};

template <class Epi>
__device__ __forceinline__ void gemm_phase(LAS unsigned char* lds, const Gemm g, const StaticOrder& S, const Epi& E) {
    const int tid = threadIdx.x, wid = __builtin_amdgcn_readfirstlane(tid >> 6), lane = tid & 63, wr = wid >> 2, wc = wid & 3, fr = lane & 15, fq = lane >> 4;
    const int K = g.K, nt = K / BK;
    unsigned voffA[2], voffB[2];
#pragma unroll
    for (int i = 0; i < 2; ++i) { int R, C; stage_rc(tid * 16 + i * 8192, R, C); const int Rb = Epi::PERM ? ((R & ~31) + perm32(R & 31)) : R;
        voffA[i] = (unsigned)(R * g.lda + C) * 2u; voffB[i] = (unsigned)(Rb * g.ldb + C) * 2u; }
    const size_t kstep = (size_t)(BK * 2);
    const size_t hstepA = (size_t)HALF * g.lda * 2, hstepB = (size_t)HALF * g.ldb * 2;
    const size_t tstepA = 2 * hstepA, tstepB = 2 * hstepB;
    const unsigned ldsw = (unsigned)wid * 1024u;
    const int aoff = lds_byte(wr * 64 + fr, fq * 8), boff = lds_byte(wc * 32 + fr, fq * 8);
#define PG8_SA(b, h) (((b) * 2 + (h)) * HTB)
#define PG8_SB(b, h) ((4 + (b) * 2 + (h)) * HTB)
#define PG8_STAGE(bufoff, gbase, voff) do { _Pragma("unroll") for (int _i = 0; _i < 2; ++_i) \
        __builtin_amdgcn_global_load_lds((const unsigned*)((const char*)(gbase) + (voff)[_i]), (LAS unsigned*)(lds + (bufoff) + ldsw + _i * 8192), 16, 0, 0); } while (0)
#define PG8_LDA(dst, b, h) do { _Pragma("unroll") for (int m = 0; m < 4; ++m) _Pragma("unroll") for (int k = 0; k < 2; ++k) dst[m][k] = *(const LAS bf16x8*)(lds + PG8_SA(b, h) + aoff + m * 2048 + k * 1024); } while (0)
#define PG8_LDB(dst, b, h) do { _Pragma("unroll") for (int n = 0; n < 2; ++n) _Pragma("unroll") for (int k = 0; k < 2; ++k) dst[n][k] = *(const LAS bf16x8*)(lds + PG8_SB(b, h) + boff + n * 2048 + k * 1024); } while (0)
#define PG8_MMA(ai, bj, At, Bt) do { __builtin_amdgcn_s_setprio(1); _Pragma("unroll") for (int m = 0; m < 4; ++m) _Pragma("unroll") for (int n = 0; n < 2; ++n) _Pragma("unroll") for (int k = 0; k < 2; ++k) \
        acc[ai][bj][m][n] = __builtin_amdgcn_mfma_f32_16x16x32_bf16(Bt[n][k], At[m][k], acc[ai][bj][m][n], 0, 0, 0); __builtin_amdgcn_s_setprio(0); } while (0)
#define PG8_WAIT_V(n) asm volatile("s_waitcnt vmcnt(" #n ")" ::: "memory")
#define PG8_WAIT_L(n) asm volatile("s_waitcnt lgkmcnt(" #n ")" ::: "memory")
#define PG8_BAR __builtin_amdgcn_s_barrier()
#define PG8_SCHED __builtin_amdgcn_sched_barrier(0)
    Unit cur, nxt; int ui = 0;
    if (!S.next(0, cur)) return;
    f32x4 acc[2][2][4][2];
#pragma unroll
    for (int a = 0; a < 2; ++a)
#pragma unroll
        for (int b = 0; b < 2; ++b)
#pragma unroll
            for (int m = 0; m < 4; ++m)
#pragma unroll
                for (int n = 0; n < 2; ++n) acc[a][b][m][n] = (f32x4){0.f, 0.f, 0.f, 0.f};
    bf16x8 At[4][2], B0[2][2], B1[2][2];
    const char* cA = (const char*)g.A + (size_t)cur.pm * tstepA + (size_t)(cur.pn >> g.gshift) * g.goff; const char* cB = (const char*)g.Bt + (size_t)cur.pn * tstepB;
    PG8_STAGE(PG8_SB(0, 0), cB, voffB); PG8_STAGE(PG8_SB(0, 1), cB + hstepB, voffB); PG8_STAGE(PG8_SA(0, 0), cA, voffA); PG8_STAGE(PG8_SA(0, 1), cA + hstepA, voffA);
    if (wr == 1) PG8_BAR;
    PG8_WAIT_V(2); PG8_BAR;
    PG8_STAGE(PG8_SB(1, 0), cB + kstep, voffB); PG8_STAGE(PG8_SA(1, 0), cA + kstep, voffA); PG8_STAGE(PG8_SB(1, 1), cB + hstepB + kstep, voffB);
    PG8_WAIT_V(6); PG8_BAR;
    for (;;) {
        const bool has_next = S.next(ui + 1, nxt);
        const char* nA = has_next ? (const char*)g.A + (size_t)nxt.pm * tstepA + (size_t)(nxt.pn >> g.gshift) * g.goff : cA; const char* nB = has_next ? (const char*)g.Bt + (size_t)nxt.pn * tstepB : cB;
        for (int t = 0; t < nt; t += 2) {
            const bool last = (t == nt - 2);
            const char* a1 = cA + (size_t)(t + 1) * kstep;
            const char* a2 = last ? nA : cA + (size_t)(t + 2) * kstep; const char* b2 = last ? nB : cB + (size_t)(t + 2) * kstep;
            const char* a3 = a2 + kstep; const char* b3 = b2 + kstep;
            PG8_LDB(B0, 0, 0); PG8_LDB(B1, 0, 1); PG8_SCHED; PG8_LDA(At, 0, 0); PG8_STAGE(PG8_SA(1, 1), a1 + hstepA, voffA);
            PG8_WAIT_V(8); PG8_WAIT_L(0); PG8_BAR; PG8_MMA(0, 0, At, B0); PG8_MMA(0, 1, At, B1); PG8_BAR; PG8_SCHED;
            PG8_LDA(At, 0, 1); PG8_STAGE(PG8_SB(0, 0), b2, voffB); PG8_STAGE(PG8_SB(0, 1), b2 + hstepB, voffB); PG8_STAGE(PG8_SA(0, 0), a2, voffA);
            PG8_WAIT_V(8); PG8_WAIT_L(0); PG8_BAR; PG8_MMA(1, 0, At, B0); PG8_MMA(1, 1, At, B1); PG8_BAR; PG8_SCHED;
            PG8_LDB(B0, 1, 0); PG8_LDB(B1, 1, 1); PG8_SCHED; PG8_LDA(At, 1, 0); PG8_STAGE(PG8_SA(0, 1), a2 + hstepA, voffA);
            PG8_WAIT_V(8); PG8_WAIT_L(0); PG8_BAR; PG8_MMA(0, 0, At, B0); PG8_MMA(0, 1, At, B1); PG8_BAR; PG8_SCHED;
            PG8_LDA(At, 1, 1); PG8_STAGE(PG8_SB(1, 0), b3, voffB); PG8_STAGE(PG8_SB(1, 1), b3 + hstepB, voffB); PG8_STAGE(PG8_SA(1, 0), a3, voffA);
            PG8_WAIT_V(8); PG8_WAIT_L(0); PG8_BAR; PG8_MMA(1, 0, At, B0); PG8_MMA(1, 1, At, B1); PG8_BAR; PG8_SCHED;
        }
        if (wr == 0) PG8_BAR;
        E(acc, cur, wr, wc, fr, fq);
        if (!has_next) break;
#pragma unroll
        for (int a = 0; a < 2; ++a)
#pragma unroll
            for (int b = 0; b < 2; ++b)
#pragma unroll
                for (int m = 0; m < 4; ++m)
#pragma unroll
                    for (int n = 0; n < 2; ++n) acc[a][b][m][n] = (f32x4){0.f, 0.f, 0.f, 0.f};
        cur = nxt; cA = nA; cB = nB; ++ui;
        if (wr == 1) PG8_BAR;
    }
    PG8_WAIT_V(0);
    PG8_BAR;
#undef PG8_SA
#undef PG8_SB
#undef PG8_STAGE
#undef PG8_LDA
#undef PG8_LDB
#undef PG8_MMA
#undef PG8_WAIT_V
#undef PG8_WAIT_L
#undef PG8_BAR
#undef PG8_SCHED
}
}
using pg8::Unit;

struct EpiQKVU {
    static constexpr bool PERM = false;
    bf16_t *Q, *Kb, *VtL, *VtC, *U; float *outk, *outv;
    __device__ __forceinline__ void operator()(const f32x4 (&acc)[2][2][4][2], const Unit& u, int wr, int wc, int fr, int fq) const {
        const int pn = u.pn; const bool lat = u.pm >= 16;
        const int rbase = u.pm * 256 + wr * 64 + fr;
        if (pn < 3) {
            float inv[4];
#pragma unroll
            for (int j = 0; j < 4; ++j) inv[j] = exp2f(-(float)(4 * fq + j) * 0.8304820237218406f);
#pragma unroll
            for (int ai = 0; ai < 2; ++ai)
#pragma unroll
                for (int m = 0; m < 4; ++m) {
                    const int r = rbase + ai * 128 + m * 16;
                    float cs[4], sn[4];
                    int t = 0, b = 0;
                    if (lat) { t = (r - MCTX) & 2047; b = (r - MCTX) >> 11; const float pos = (float)((wc & 1) ? (t & 63) : (t >> 6));
#pragma unroll
                        for (int j = 0; j < 4; ++j) { const float ang = pos * inv[j]; sn[j] = __sinf(ang); cs[j] = __cosf(ang); } }
                    else { t = r & 255; b = r >> 8;
#pragma unroll
                        for (int j = 0; j < 4; ++j) { sn[j] = 0.f; cs[j] = 1.f; } }
#pragma unroll
                    for (int bj = 0; bj < 2; ++bj) {
                        const f32x4 x1 = acc[ai][bj][m][0], x2 = acc[ai][bj][m][1];
                        if (pn == 2 && bj == 1) {
#pragma unroll
                            for (int n = 0; n < 2; ++n) {
                                const f32x4 x = n ? x2 : x1;
                                const int c0 = wc * 32 + n * 16 + 4 * fq;
#pragma unroll
                                for (int j = 0; j < 4; ++j) { const int c = c0 + j, kvh = c >> 6, d = c & 63;
                                    const bf16_t hv = (bf16_t)(cvt_pk_bf16(x[j], 0.f) & 0xffffu);
                                    if (lat) VtL[((size_t)((b * 2 + kvh) * 64 + d)) * 2048 + t] = hv; else VtC[((size_t)((b * 2 + kvh) * 64 + d)) * 256 + t] = hv; }
                                if (!lat) *(f32x4*)(outv + (size_t)r * 128 + c0) = x;
                            }
                        } else {
                            f32x4 o1, o2;
#pragma unroll
                            for (int j = 0; j < 4; ++j) { o1[j] = x1[j] * cs[j] - x2[j] * sn[j]; o2[j] = x2[j] * cs[j] + x1[j] * sn[j]; }
                            if (pn < 2) {
                                bf16_t* dst = Q + (size_t)r * 512 + pn * 256 + bj * 128 + wc * 32 + 4 * fq;
                                u32x2 w1, w2; w1.x = cvt_pk_bf16(o1[0] * 0.125f, o1[1] * 0.125f); w1.y = cvt_pk_bf16(o1[2] * 0.125f, o1[3] * 0.125f);
                                w2.x = cvt_pk_bf16(o2[0] * 0.125f, o2[1] * 0.125f); w2.y = cvt_pk_bf16(o2[2] * 0.125f, o2[3] * 0.125f);
                                *(u32x2*)dst = w1; *(u32x2*)(dst + 16) = w2;
                            } else {
                                const int c0 = wc * 32 + 4 * fq;
                                bf16_t* dst = Kb + (size_t)r * 128 + c0;
                                u32x2 w1, w2; w1.x = cvt_pk_bf16(o1[0], o1[1]); w1.y = cvt_pk_bf16(o1[2], o1[3]); w2.x = cvt_pk_bf16(o2[0], o2[1]); w2.y = cvt_pk_bf16(o2[2], o2[3]);
                                *(u32x2*)dst = w1; *(u32x2*)(dst + 16) = w2;
                                if (!lat) { *(f32x4*)(outk + (size_t)r * 128 + c0) = o1; *(f32x4*)(outk + (size_t)r * 128 + c0 + 16) = o2; }
                            }
                        }
                    }
                }
        } else {
            const int chb = (pn - 3) * 128 + wc * 32 + 4 * fq;
#pragma unroll
            for (int ai = 0; ai < 2; ++ai)
#pragma unroll
                for (int m = 0; m < 4; ++m) {
                    const int r = rbase + ai * 128 + m * 16;
#pragma unroll
                    for (int n = 0; n < 2; ++n) {
                        const f32x4 a = acc[ai][0][m][n], gt = acc[ai][1][m][n];
                        u32x2 w; w.x = cvt_pk_bf16(a[0] * sigmoidf_(gt[0]), a[1] * sigmoidf_(gt[1])); w.y = cvt_pk_bf16(a[2] * sigmoidf_(gt[2]), a[3] * sigmoidf_(gt[3]));
                        *(u32x2*)(U + (size_t)r * 512 + chb + n * 16) = w;
                    }
                }
        }
    }
};

template <bool FROMX> struct EpiResid {
    static constexpr bool PERM = false;
    const float* xp; const float* xs; float* Y; const float* gate;
    __device__ __forceinline__ void operator()(const f32x4 (&acc)[2][2][4][2], const Unit& u, int wr, int wc, int fr, int fq) const {
        const int mi = u.pm < 16 ? 0 : 1 + ((u.pm - 16) >> 3);
        const float* gp = gate + mi * 6144;
        const int rbase = u.pm * 256 + wr * 64 + fr;
#pragma unroll
        for (int bj = 0; bj < 2; ++bj)
#pragma unroll
            for (int n = 0; n < 2; ++n) {
                const int col = u.pn * 256 + bj * 128 + wc * 32 + n * 16 + 4 * fq;
                const f32x4 g4 = *(const f32x4*)(gp + col);
#pragma unroll
                for (int ai = 0; ai < 2; ++ai)
#pragma unroll
                    for (int m = 0; m < 4; ++m) {
                        const int r = rbase + ai * 128 + m * 16;
                        const float* bp = FROMX ? (u.pm < 16 ? xp + (size_t)r * 1024 : xs + (size_t)(r - MCTX) * 1024) : Y + (size_t)r * 1024;
                        const f32x4 b4 = *(const f32x4*)(bp + col);
                        *(f32x4*)(Y + (size_t)r * 1024 + col) = b4 + g4 * acc[ai][bj][m][n];
                    }
            }
    }
};

struct EpiSqRelu {
    static constexpr bool PERM = true;
    bf16_t* F;
    __device__ __forceinline__ void operator()(const f32x4 (&acc)[2][2][4][2], const Unit& u, int wr, int wc, int fr, int fq) const {
        const int rbase = u.pm * 256 + wr * 64 + fr, col0 = u.pn * 256 + wc * 32 + 8 * fq;
#pragma unroll
        for (int ai = 0; ai < 2; ++ai)
#pragma unroll
            for (int m = 0; m < 4; ++m) { bf16_t* rowp = F + (size_t)(rbase + ai * 128 + m * 16) * 4096 + col0;
#pragma unroll
                for (int bj = 0; bj < 2; ++bj) { f32x4 v0 = acc[ai][bj][m][0], v1 = acc[ai][bj][m][1];
#pragma unroll
                    for (int j = 0; j < 4; ++j) { const float a = fmaxf(v0[j], 0.f), b = fmaxf(v1[j], 0.f); v0[j] = a * a; v1[j] = b * b; }
                    u32x4 w; w.x = cvt_pk_bf16(v0[0], v0[1]); w.y = cvt_pk_bf16(v0[2], v0[3]); w.z = cvt_pk_bf16(v1[0], v1[1]); w.w = cvt_pk_bf16(v1[2], v1[3]);
                    *(u32x4*)(rowp + bj * 128) = w; } }
    }
};

__device__ __forceinline__ float gelu_tanh(float x) { const float u2 = 1.5957691216057308f * (x + 0.044715f * x * x * x); return x / (1.0f + __expf(-u2)); }

struct EpiLruIn {
    static constexpr bool PERM = true;
    bf16_t *G, *R;
    __device__ __forceinline__ void operator()(const f32x4 (&acc)[2][2][4][2], const Unit& u, int wr, int wc, int fr, int fq) const {
        const bool isg = u.pn < 4;
        bf16_t* O = isg ? G : R;
        const int rbase = u.pm * 256 + wr * 64 + fr, col0 = (u.pn & 3) * 256 + wc * 32 + 8 * fq;
#pragma unroll
        for (int ai = 0; ai < 2; ++ai)
#pragma unroll
            for (int m = 0; m < 4; ++m) { bf16_t* rowp = O + (size_t)(rbase + ai * 128 + m * 16) * 1024 + col0;
#pragma unroll
                for (int bj = 0; bj < 2; ++bj) { f32x4 v0 = acc[ai][bj][m][0], v1 = acc[ai][bj][m][1];
                    if (isg) {
#pragma unroll
                        for (int j = 0; j < 4; ++j) { v0[j] = gelu_tanh(v0[j]); v1[j] = gelu_tanh(v1[j]); } }
                    u32x4 w; w.x = cvt_pk_bf16(v0[0], v0[1]); w.y = cvt_pk_bf16(v0[2], v0[3]); w.z = cvt_pk_bf16(v1[0], v1[1]); w.w = cvt_pk_bf16(v1[2], v1[3]);
                    *(u32x4*)(rowp + bj * 128) = w; } }
    }
};

struct EpiGates {
    static constexpr bool PERM = false;
    const bf16_t* XC; unsigned* LB; const float *ba, *bx, *lam;
    __device__ __forceinline__ void operator()(const f32x4 (&acc)[2][2][4][2], const Unit& u, int wr, int wc, int fr, int fq) const {
        const int dir = u.pn & 1, grp = u.pn >> 1;
        const int rbase = u.pm * 256 + wr * 64 + fr;
#pragma unroll
        for (int n = 0; n < 2; ++n) {
            const int chb = grp * 128 + wc * 32 + n * 16 + 4 * fq;
            const f32x4 ba4 = *(const f32x4*)(ba + dir * 1024 + chb), bx4 = *(const f32x4*)(bx + dir * 1024 + chb), lm4 = *(const f32x4*)(lam + dir * 1024 + chb);
            float lu[4];
#pragma unroll
            for (int j = 0; j < 4; ++j) { const float e = __expf(-lm4[j]); lu[j] = -8.0f * e * (1.0f - e * (0.5f - e * (0.33333333f - e * 0.25f))); }
#pragma unroll
            for (int ai = 0; ai < 2; ++ai)
#pragma unroll
                for (int m = 0; m < 4; ++m) {
                    const int r = rbase + ai * 128 + m * 16;
                    const u32x2 xw = *(const u32x2*)(XC + (size_t)r * 1024 + chb);
                    const float xc[4] = {bflo(xw.x), bfhi(xw.x), bflo(xw.y), bfhi(xw.y)};
                    const f32x4 pr = acc[ai][0][m][n] + ba4, pi = acc[ai][1][m][n] + bx4;
                    u32x4 w;
#pragma unroll
                    for (int j = 0; j < 4; ++j) { const float rr = sigmoidf_(pr[j]), ii = sigmoidf_(pi[j]); const float la = rr * lu[j];
                        const float a2 = __expf(2.0f * la); const float bb = sqrtf(fmaxf(1.0f - a2, 0.f)) * ii * xc[j]; w[j] = cvt_pk_bf16(la, bb); }
                    *(u32x4*)(LB + ((size_t)dir * MT + r) * 1024 + chb) = w;
                    asm volatile("" ::: "memory");
                }
        }
    }
};

struct TJob { const float* src; bf16_t* dst; int K, N, ldd, kind; };
constexpr int N_ADA = 192, N_TR0 = 176, N_CACHE = 32;
constexpr int N_TR1 = 512;
constexpr int N_TR2 = 768;

template <int NC>
__device__ __forceinline__ void transpose_item(const TJob& j, LAS unsigned char* lds, int k0, int n0) {
    const int tid = threadIdx.x;
    constexpr int TPR = NC / 4, RPP = 512 / TPR, NL = 64 / RPP;
    f32x4 v[NL];
#pragma unroll
    for (int i = 0; i < NL; ++i) { const int kk = tid / TPR + RPP * i, n4 = tid % TPR; v[i] = *(const f32x4*)(j.src + (size_t)(k0 + kk) * j.N + n0 + 4 * n4); }
    LAS bf16_t* tile = (LAS bf16_t*)lds;
#pragma unroll
    for (int i = 0; i < NL; ++i) { const int kk = tid / TPR + RPP * i, n4 = tid % TPR;
#pragma unroll
        for (int e = 0; e < 4; ++e) tile[(4 * n4 + e) * 72 + kk] = (bf16_t)(cvt_pk_bf16(v[i][e], 0.f) & 0xffffu); }
    __syncthreads();
#pragma unroll
    for (int i = 0; i < NC / 64; ++i) { const int nl = (tid >> 3) + 64 * i, k8 = tid & 7; int n = n0 + nl;
        if (j.kind == 1 && n >= 768) { const int np = n - 768, sel = np >> 9, chn = np & 511; n = 768 + (chn >> 7) * 256 + sel * 128 + (chn & 127); }
        const u32x4 w = *(const LAS u32x4*)(lds + nl * 144 + k8 * 16);
        *(u32x4*)(j.dst + (size_t)n * j.ldd + k0 + 8 * k8) = w; }
    __syncthreads();
}

__device__ __forceinline__ void transpose_group(const Params& p, LAS unsigned char* lds, int grp, int t) {
    unsigned char* ws = p.ws; TJob j;
    if (grp == 0) {
        if (t < 112) j = {p.in[13], (bf16_t*)(ws + WS_WATTIN), 1024, 1792, 1024, 1};
        else { t -= 112; j = {p.in[14], (bf16_t*)(ws + WS_WATTOUT), 1024, 1024, 1024, 0}; }
    } else if (grp == 1) {
        if (t < 256) j = {p.in[11], (bf16_t*)(ws + WS_WFF1), 1024, 4096, 1024, 0};
        else { t -= 256; j = {p.in[12], (bf16_t*)(ws + WS_WFF2), 4096, 1024, 4096, 0}; }
    } else {
        if (t < 256) j = {p.in[11] + (size_t)1024 * 4096, (bf16_t*)(ws + WS_WFF1) + (size_t)4096 * 1024, 1024, 4096, 1024, 0};
        else if ((t -= 256) < 256) j = {p.in[12] + (size_t)4096 * 1024, (bf16_t*)(ws + WS_WFF2) + (size_t)1024 * 4096, 4096, 1024, 4096, 0};
        else if ((t -= 256) < 128) j = {p.in[20], (bf16_t*)(ws + WS_WLRUIN), 1024, 2048, 1024, 0};
        else if ((t -= 128) < 64) j = {p.in[21], (bf16_t*)(ws + WS_WLRUOUT), 1024, 1024, 1024, 0};
        else { t -= 64; const int mtx = t >> 1; const int which = mtx >> 4, dir = (mtx >> 3) & 1, blk = mtx & 7;
            j = {(which ? p.in[26] : p.in[24]) + (size_t)(dir * 8 + blk) * 16384, (bf16_t*)(ws + WS_WG) + (size_t)(blk * 512 + dir * 256 + which * 128) * 128, 128, 128, 128, 0};
            transpose_item<128>(j, lds, (t & 1) * 64, 0); return; }
    }
    const int nn = j.N >> 8;
    transpose_item<256>(j, lds, (t / nn) * 64, (t % nn) * 256);
}

__device__ __forceinline__ void phase_prep(const Params& p, LAS unsigned char* lds) {
    const int tid = threadIdx.x;
    unsigned char* ws = p.ws;
    for (int it = blockIdx.x; it < N_ADA + N_TR0 + N_CACHE; it += gridDim.x) {
        if (it < N_ADA) {
            const int l = it / 96, n0 = (it % 96) * 64;
            LAS float* sc = (LAS float*)lds;
            LAS float* red = (LAS float*)(lds + 20480);
            for (int i = tid; i < 5120; i += 512) { const int j = i >> 10, k = i & 1023; const float x = (j == 0) ? p.in[6][k] : p.in[2][(j - 1) * 1024 + k]; sc[i] = x / (1.0f + __expf(-x)); }
            __syncthreads();
            const int col = tid & 63, kg = tid >> 6;
            const float* w = p.in[7] + (size_t)l * 1024 * 6144 + (size_t)(kg * 128) * 6144 + n0 + col;
            float a0 = 0.f, a1 = 0.f, a2 = 0.f, a3 = 0.f, a4 = 0.f;
#pragma unroll 1
            for (int kb = 0; kb < 128; kb += 32) { float wv[32];
#pragma unroll
                for (int k = 0; k < 32; ++k) wv[k] = w[(size_t)(kb + k) * 6144];
#pragma unroll
                for (int k = 0; k < 32; ++k) { const int kk = kg * 128 + kb + k;
                    a0 += sc[kk] * wv[k]; a1 += sc[1024 + kk] * wv[k]; a2 += sc[2048 + kk] * wv[k]; a3 += sc[3072 + kk] * wv[k]; a4 += sc[4096 + kk] * wv[k]; } }
            red[(kg * 5 + 0) * 64 + col] = a0; red[(kg * 5 + 1) * 64 + col] = a1; red[(kg * 5 + 2) * 64 + col] = a2; red[(kg * 5 + 3) * 64 + col] = a3; red[(kg * 5 + 4) * 64 + col] = a4;
            __syncthreads();
            if (tid < 320) { const int j = tid >> 6; float s = 0.f;
#pragma unroll
                for (int g = 0; g < 8; ++g) s += red[(g * 5 + j) * 64 + col];
                ((float*)(ws + WS_MOD))[(l * 5 + j) * 6144 + n0 + col] = s + p.in[8][l * 6144 + n0 + col]; }
            __syncthreads();
        } else if (it < N_ADA + N_TR0) {
            transpose_group(p, lds, 0, it - N_ADA);
        } else {
            const int ci = it - N_ADA - N_TR0;
            bf16_t* cK = (bf16_t*)(ws + WS_CK); bf16_t* cVt = (bf16_t*)(ws + WS_CVT);
            for (int e = tid; e < 4096; e += 512) { const int o = ci * 4096 + e;
                { const int d = o & 63, t = (o >> 6) & 255, kvh = (o >> 14) & 1, b = o >> 15; cK[o] = (bf16_t)(cvt_pk_bf16(p.in[3][((size_t)(b * 256 + t) * 2 + kvh) * 64 + d], 0.f) & 0xffffu); }
                { const int t = o & 255, d = (o >> 8) & 63, kvh = (o >> 14) & 1, b = o >> 15; cVt[o] = (bf16_t)(cvt_pk_bf16(p.in[4][((size_t)(b * 256 + t) * 2 + kvh) * 64 + d], 0.f) & 0xffffu); } }
        }
    }
}

template <int MODE>
__device__ __forceinline__ void phase_norm(const Params& p, const float* gvec, const float* modl, int ch_shift, int ch_scale) {
    const int lane = threadIdx.x & 63, wid = threadIdx.x >> 6;
    bf16_t* HA = (bf16_t*)(p.ws + WS_HA);
    constexpr int RB = 3;
    const int nw = gridDim.x * 8;
    for (int row0 = blockIdx.x * 8 + wid; row0 < MT; row0 += nw * RB) {
        f32x4 v[RB][4];
#pragma unroll
        for (int q = 0; q < RB; ++q) { const int row = row0 + q * nw;
            if (row < MT) { const float* src = (MODE == 0) ? (row < MCTX ? p.in[0] + (size_t)row * 1024 : p.in[1] + (size_t)(row - MCTX) * 1024) : p.out + (size_t)row * 1024;
#pragma unroll
                for (int i = 0; i < 4; ++i) v[q][i] = *(const f32x4*)(src + i * 256 + lane * 4); }
            else {
#pragma unroll
                for (int i = 0; i < 4; ++i) v[q][i] = (f32x4){0.f, 0.f, 0.f, 0.f}; } }
#pragma unroll
        for (int q = 0; q < RB; ++q) { const int row = row0 + q * nw;
            float ss = 0.f;
#pragma unroll
            for (int i = 0; i < 4; ++i) ss += v[q][i][0] * v[q][i][0] + v[q][i][1] * v[q][i][1] + v[q][i][2] * v[q][i][2] + v[q][i][3] * v[q][i][3];
#pragma unroll
            for (int o = 32; o >= 1; o >>= 1) ss += __shfl_xor(ss, o);
            const float rstd = rsqrtf(ss * (1.0f / 1024.0f) + 1e-6f);
            if (row < MT) {
                const int mi = row < MCTX ? 0 : 1 + ((row - MCTX) >> 11);
#pragma unroll
                for (int i = 0; i < 4; ++i) { const int c = i * 256 + lane * 4; const f32x4 g4 = *(const f32x4*)(gvec + c);
                    f32x4 o = v[q][i] * rstd * g4;
                    if (MODE < 2) { const f32x4 sc = *(const f32x4*)(modl + mi * 6144 + ch_scale * 1024 + c), sh = *(const f32x4*)(modl + mi * 6144 + ch_shift * 1024 + c);
                        o = o * (sc + 1.0f) + sh;
                        u32x2 w; w.x = cvt_pk_bf16(o[0], o[1]); w.y = cvt_pk_bf16(o[2], o[3]); *(u32x2*)(HA + (size_t)row * 1024 + c) = w; }
                    else *(f32x4*)(p.out + (size_t)row * 1024 + c) = o; } } }
    }
}

constexpr int SV_OFF = 128 * 144;
__device__ __forceinline__ void attn_item(const Params& p, LAS unsigned char* lds, int it) {
    const int tid = threadIdx.x, lane = tid & 63, wid = tid >> 6, fr = lane & 15, fq = lane >> 4;
    unsigned char* ws = p.ws;
    const bf16_t* Q = (const bf16_t*)(ws + WS_Q); const bf16_t* Kb = (const bf16_t*)(ws + WS_KB);
    const bf16_t* VtL = (const bf16_t*)(ws + WS_VTL); const bf16_t* VtC = (const bf16_t*)(ws + WS_VTC);
    const bf16_t* cK = (const bf16_t*)(ws + WS_CK); const bf16_t* cVt = (const bf16_t*)(ws + WS_CVT);
    bf16_t* MIX = (bf16_t*)(ws + WS_MIX);
    const bool lat = it < 128;
    int b, kvh, n = 0, row0;
    if (lat) { b = it >> 5; kvh = (it >> 4) & 1; n = it & 15; row0 = MCTX + b * 2048 + n * 128; }
    else { const int i2 = it - 128; b = i2 >> 2; kvh = (i2 >> 1) & 1; row0 = b * 256 + (i2 & 1) * 128; }
    const int g = wid >> 1, qoff = (wid & 1) * 64, h = kvh * 4 + g;
    bf16x8 qreg[4][2];
#pragma unroll
    for (int qs = 0; qs < 4; ++qs)
#pragma unroll
        for (int dh = 0; dh < 2; ++dh) qreg[qs][dh] = *(const bf16x8*)(Q + (size_t)(row0 + qoff + qs * 16 + fr) * 512 + h * 64 + dh * 32 + fq * 8);
    const float sink = p.in[15][h];
    float m_[4], l_[4]; f32x4 o[4][4];
#pragma unroll
    for (int qs = 0; qs < 4; ++qs) { m_[qs] = sink; l_[qs] = (fq == 0) ? 1.0f : 0.0f;
#pragma unroll
        for (int ds = 0; ds < 4; ++ds) o[qs][ds] = (f32x4){0.f, 0.f, 0.f, 0.f}; }
    const int nch = lat ? 5 : 2;
    for (int c = 0; c < nch; ++c) {
        const bf16_t* kp; const bf16_t* vp; int kpitch, vpitch, mtype = 0;
        if (lat) {
            if (c < 3) { const int cb = n - 1 + c; if (cb < 0 || cb > 15) continue;
                kp = Kb + (size_t)(MCTX + b * 2048 + cb * 128) * 128 + kvh * 64; kpitch = 128; vp = VtL + (size_t)((b * 2 + kvh) * 64) * 2048 + cb * 128; vpitch = 2048; mtype = (c == 0) ? 1 : (c == 2 ? 2 : 0); }
            else { const int cc = c - 3; kp = cK + (size_t)((b * 2 + kvh) * 256 + cc * 128) * 64; kpitch = 64; vp = cVt + (size_t)((b * 2 + kvh) * 64) * 256 + cc * 128; vpitch = 256; }
        } else { kp = Kb + (size_t)(b * 256 + c * 128) * 128 + kvh * 64; kpitch = 128; vp = VtC + (size_t)((b * 2 + kvh) * 64) * 256 + c * 128; vpitch = 256; }
        __syncthreads();
#pragma unroll
        for (int e = 0; e < 2; ++e) { const int pc = tid + e * 512; const int key = pc >> 3, d8 = pc & 7;
            const u32x4 v = *(const u32x4*)(kp + (size_t)key * kpitch + d8 * 8); *(LAS u32x4*)(lds + key * 144 + d8 * 16) = v; }
#pragma unroll
        for (int e = 0; e < 2; ++e) { const int pc = tid + e * 512; const int d = pc >> 4, k8 = pc & 15;
            const u32x4 v = *(const u32x4*)(vp + (size_t)d * vpitch + k8 * 8); *(LAS u32x4*)(lds + SV_OFF + d * 272 + k8 * 16) = v; }
        __syncthreads();
#pragma unroll 1
        for (int ks = 0; ks < 4; ++ks) {
            bf16x8 kreg[2][2], vreg[4];
#pragma unroll
            for (int kt = 0; kt < 2; ++kt)
#pragma unroll
                for (int dh = 0; dh < 2; ++dh) kreg[kt][dh] = *(const LAS bf16x8*)(lds + (ks * 32 + kt * 16 + fr) * 144 + (dh * 32 + fq * 8) * 2);
#pragma unroll
            for (int ds = 0; ds < 4; ++ds) { const u32x2 lo = *(const LAS u32x2*)(lds + SV_OFF + (ds * 16 + fr) * 272 + (ks * 32 + 4 * fq) * 2);
                const u32x2 hi = *(const LAS u32x2*)(lds + SV_OFF + (ds * 16 + fr) * 272 + (ks * 32 + 16 + 4 * fq) * 2);
                const u32x4 vv = {lo.x, lo.y, hi.x, hi.y}; vreg[ds] = __builtin_bit_cast(bf16x8, vv); }
#pragma unroll
            for (int qs = 0; qs < 4; ++qs) {
                f32x4 s0 = {0.f, 0.f, 0.f, 0.f}, s1 = {0.f, 0.f, 0.f, 0.f};
                s0 = __builtin_amdgcn_mfma_f32_16x16x32_bf16(kreg[0][0], qreg[qs][0], s0, 0, 0, 0); s0 = __builtin_amdgcn_mfma_f32_16x16x32_bf16(kreg[0][1], qreg[qs][1], s0, 0, 0, 0);
                s1 = __builtin_amdgcn_mfma_f32_16x16x32_bf16(kreg[1][0], qreg[qs][0], s1, 0, 0, 0); s1 = __builtin_amdgcn_mfma_f32_16x16x32_bf16(kreg[1][1], qreg[qs][1], s1, 0, 0, 0);
                if (mtype) { const int ii = qoff + qs * 16 + fr;
#pragma unroll
                    for (int j = 0; j < 4; ++j) { const int j0 = ks * 32 + 4 * fq + j, j1 = j0 + 16;
                        const bool v0 = (mtype == 1) ? (j0 >= ii) : (j0 <= ii), v1 = (mtype == 1) ? (j1 >= ii) : (j1 <= ii);
                        if (!v0) s0[j] = -1e30f; if (!v1) s1[j] = -1e30f; } }
                float mx = fmaxf(fmaxf(fmaxf(s0[0], s0[1]), fmaxf(s0[2], s0[3])), fmaxf(fmaxf(s1[0], s1[1]), fmaxf(s1[2], s1[3])));
                mx = fmaxf(mx, __shfl_xor(mx, 16)); mx = fmaxf(mx, __shfl_xor(mx, 32));
                const float mn = fmaxf(m_[qs], mx), alpha = __expf(m_[qs] - mn); m_[qs] = mn;
                float ps = 0.f;
#pragma unroll
                for (int j = 0; j < 4; ++j) { s0[j] = __expf(s0[j] - mn); s1[j] = __expf(s1[j] - mn); ps += s0[j] + s1[j]; }
                l_[qs] = l_[qs] * alpha + ps;
                const u32x4 pw = {cvt_pk_bf16(s0[0], s0[1]), cvt_pk_bf16(s0[2], s0[3]), cvt_pk_bf16(s1[0], s1[1]), cvt_pk_bf16(s1[2], s1[3])};
                const bf16x8 pb = __builtin_bit_cast(bf16x8, pw);
#pragma unroll
                for (int ds = 0; ds < 4; ++ds) { o[qs][ds] = o[qs][ds] * alpha; o[qs][ds] = __builtin_amdgcn_mfma_f32_16x16x32_bf16(vreg[ds], pb, o[qs][ds], 0, 0, 0); }
            }
        }
    }
#pragma unroll
    for (int qs = 0; qs < 4; ++qs) { float lt = l_[qs]; lt += __shfl_xor(lt, 16); lt += __shfl_xor(lt, 32); const float inv = 1.0f / lt;
        bf16_t* dst = MIX + (size_t)(row0 + qoff + qs * 16 + fr) * 1024 + h * 64 + 4 * fq;
#pragma unroll
        for (int ds = 0; ds < 4; ++ds) { const f32x4 v = o[qs][ds] * inv; u32x2 w; w.x = cvt_pk_bf16(v[0], v[1]); w.y = cvt_pk_bf16(v[2], v[3]); *(u32x2*)(dst + ds * 16) = w; } }
}

__device__ __forceinline__ void conv_item(const Params& p, LAS unsigned char* lds, int ci) {
    const int tid = threadIdx.x, lane = tid & 63, wid = tid >> 6;
    const bf16_t* U = (const bf16_t*)(p.ws + WS_U); bf16_t* MIX = (bf16_t*)(p.ws + WS_MIX);
    const int row0 = ci * 32;
    int s0, s1; if (row0 < MCTX) { s0 = row0 & ~255; s1 = s0 + 256; } else { s0 = MCTX + ((row0 - MCTX) & ~2047); s1 = s0 + 2048; }
    __syncthreads();
    for (int pc = tid; pc < 62 * 64; pc += 512) { const int rr = pc >> 6, c8 = pc & 63, grow = row0 - 15 + rr; u32x4 v = {0u, 0u, 0u, 0u};
        if (grow >= s0 && grow < s1) v = *(const u32x4*)(U + (size_t)grow * 512 + c8 * 8);
        *(LAS u32x4*)(lds + rr * 1024 + c8 * 16) = v; }
    __syncthreads();
    const int cp = tid & 255, th = tid >> 8;
    float w0[31], w1[31];
#pragma unroll
    for (int k = 0; k < 31; ++k) { const f32x2 wv = *(const f32x2*)(p.in[16] + k * 512 + 2 * cp); w0[k] = wv.x; w1[k] = wv.y; }
    const f32x2 bv = *(const f32x2*)(p.in[17] + 2 * cp);
    LAS f32x2* zb = (LAS f32x2*)(lds + 65536);
#pragma unroll 1
    for (int tt = 0; tt < 16; ++tt) { const int t = th * 16 + tt; float a0 = bv.x, a1 = bv.y;
#pragma unroll
        for (int k = 0; k < 31; ++k) { const unsigned x = *(const LAS unsigned*)(lds + (t + k) * 1024 + cp * 4); a0 += w0[k] * bflo(x); a1 += w1[k] * bfhi(x); }
        zb[t * 256 + cp] = (f32x2){a0, a1}; }
    __syncthreads();
    const f32x4 g0 = *(const f32x4*)(p.in[18] + lane * 8), g1 = *(const f32x4*)(p.in[18] + lane * 8 + 4), be0 = *(const f32x4*)(p.in[19] + lane * 8), be1 = *(const f32x4*)(p.in[19] + lane * 8 + 4);
#pragma unroll 1
    for (int q = 0; q < 4; ++q) { const int t = wid * 4 + q;
        const LAS float* zr = (const LAS float*)(lds + 65536 + t * 2048);
        f32x4 v0 = *(const LAS f32x4*)(zr + lane * 8), v1 = *(const LAS f32x4*)(zr + lane * 8 + 4);
        float s = (v0[0] + v0[1]) + (v0[2] + v0[3]) + (v1[0] + v1[1]) + (v1[2] + v1[3]);
#pragma unroll
        for (int o = 32; o >= 1; o >>= 1) s += __shfl_xor(s, o);
        const float mean = s * (1.0f / 512.0f);
        v0 = v0 - mean; v1 = v1 - mean;
        float qv = (v0[0] * v0[0] + v0[1] * v0[1]) + (v0[2] * v0[2] + v0[3] * v0[3]) + (v1[0] * v1[0] + v1[1] * v1[1]) + (v1[2] * v1[2] + v1[3] * v1[3]);
#pragma unroll
        for (int o = 32; o >= 1; o >>= 1) qv += __shfl_xor(qv, o);
        const float rstd = rsqrtf(qv * (1.0f / 512.0f) + 1e-6f);
        v0 = v0 * rstd * g0 + be0; v1 = v1 * rstd * g1 + be1;
#pragma unroll
        for (int j = 0; j < 4; ++j) { v0[j] = v0[j] * sigmoidf_(v0[j]); v1[j] = v1[j] * sigmoidf_(v1[j]); }
        u32x4 w; w.x = cvt_pk_bf16(v0[0], v0[1]); w.y = cvt_pk_bf16(v0[2], v0[3]); w.z = cvt_pk_bf16(v1[0], v1[1]); w.w = cvt_pk_bf16(v1[2], v1[3]);
        *(u32x4*)(MIX + (size_t)(row0 + t) * 1024 + 512 + lane * 8) = w; }
}

__device__ __forceinline__ void phase_conv4(const Params& p) {
    const bf16_t* __restrict__ R = (const bf16_t*)(p.ws + WS_R); bf16_t* __restrict__ XC = (bf16_t*)(p.ws + WS_HA);
    const int c8 = threadIdx.x & 127, rsub = threadIdx.x >> 7;
    f32x4 w0[4], w1[4];
#pragma unroll
    for (int k = 0; k < 4; ++k) { w0[k] = *(const f32x4*)(p.in[22] + k * 1024 + c8 * 8); w1[k] = *(const f32x4*)(p.in[22] + k * 1024 + c8 * 8 + 4); }
    const f32x4 b0 = *(const f32x4*)(p.in[23] + c8 * 8), b1 = *(const f32x4*)(p.in[23] + c8 * 8 + 4);
    for (int g = blockIdx.x; g < MT / 16; g += gridDim.x) {
        const int r0 = g * 16 + rsub * 4;
        int s0, s1; if (r0 < MCTX) { s0 = r0 & ~255; s1 = s0 + 256; } else { s0 = MCTX + ((r0 - MCTX) & ~2047); s1 = s0 + 2048; }
        u32x4 x[7];
#pragma unroll
        for (int i = 0; i < 7; ++i) { const int rr = r0 - 1 + i; x[i] = (u32x4){0u, 0u, 0u, 0u}; if (rr >= s0 && rr < s1) x[i] = *(const u32x4*)(R + (size_t)rr * 1024 + c8 * 8); }
#pragma unroll
        for (int q = 0; q < 4; ++q) { f32x4 a0 = b0, a1 = b1;
#pragma unroll
            for (int k = 0; k < 4; ++k) { const u32x4 xv = x[q + k];
                a0[0] += w0[k][0] * bflo(xv.x); a0[1] += w0[k][1] * bfhi(xv.x); a0[2] += w0[k][2] * bflo(xv.y); a0[3] += w0[k][3] * bfhi(xv.y);
                a1[0] += w1[k][0] * bflo(xv.z); a1[1] += w1[k][1] * bfhi(xv.z); a1[2] += w1[k][2] * bflo(xv.w); a1[3] += w1[k][3] * bfhi(xv.w); }
            u32x4 w; w.x = cvt_pk_bf16(a0[0], a0[1]); w.y = cvt_pk_bf16(a0[2], a0[3]); w.z = cvt_pk_bf16(a1[0], a1[1]); w.w = cvt_pk_bf16(a1[2], a1[3]);
            *(u32x4*)(XC + (size_t)(r0 + q) * 1024 + c8 * 8) = w; }
    }
}

constexpr int CH = 64, NCHUNK = MT / CH;
__device__ __forceinline__ void phase_scan_sum(const Params& p) {
    const unsigned* __restrict__ LB = (const unsigned*)(p.ws + WS_LB); float* __restrict__ SUM = (float*)(p.ws + WS_SUM);
    const int cp = threadIdx.x;
    for (int bi = blockIdx.x; bi < NCHUNK * 2; bi += gridDim.x) {
        const int c = bi >> 1, dir = bi & 1;
        const unsigned* base = LB + ((size_t)dir * MT + (size_t)c * CH) * 1024 + 2 * cp;
        float A0 = 1.f, A1 = 1.f, B0 = 0.f, B1 = 0.f;
#pragma unroll 1
        for (int ib = 0; ib < CH; ib += 16) { u32x2 w[16];
#pragma unroll
            for (int i = 0; i < 16; ++i) { const int t = dir ? (CH - 1 - ib - i) : (ib + i); w[i] = *(const u32x2*)(base + (size_t)t * 1024); }
#pragma unroll
            for (int i = 0; i < 16; ++i) { const float a0 = __expf(bflo(w[i].x)), a1 = __expf(bflo(w[i].y)); B0 = a0 * B0 + bfhi(w[i].x); B1 = a1 * B1 + bfhi(w[i].y); A0 *= a0; A1 *= a1; } }
        *(f32x4*)(SUM + ((size_t)(c * 2 + dir) * 1024 + 2 * cp) * 2) = (f32x4){A0, B0, A1, B1};
    }
}

__device__ __forceinline__ void phase_scan_final(const Params& p) {
    unsigned* LB = (unsigned*)(p.ws + WS_LB); const float* __restrict__ SUM = (const float*)(p.ws + WS_SUM);
    const unsigned* __restrict__ G = (const unsigned*)(p.ws + WS_G); unsigned* __restrict__ YA = (unsigned*)(p.ws + WS_R);
    float* __restrict__ outh = p.out + 13631488;
    const int cp = threadIdx.x;
    for (int c = blockIdx.x; c < NCHUNK; c += gridDim.x) {
        const int row0 = c * CH; const bool ctx = row0 < MCTX;
        int cs0, ncs, b; if (ctx) { b = row0 >> 8; cs0 = b * 4; ncs = 4; } else { b = (row0 - MCTX) >> 11; cs0 = 64 + b * 32; ncs = 32; }
        float hf0 = 0.f, hf1 = 0.f, hb0 = 0.f, hb1 = 0.f;
        if (!ctx) { const f32x2 f = *(const f32x2*)(p.in[5] + (size_t)(b * 2 + 0) * 1024 + 2 * cp), bk = *(const f32x2*)(p.in[5] + (size_t)(b * 2 + 1) * 1024 + 2 * cp); hf0 = f.x; hf1 = f.y; hb0 = bk.x; hb1 = bk.y; }
        const int nf = c - cs0, nb = cs0 + ncs - 1 - c;
        for (int k0 = 0; k0 < nf; k0 += 8) { f32x4 sv[8];
#pragma unroll
            for (int k = 0; k < 8; ++k) { sv[k] = (f32x4){1.f, 0.f, 1.f, 0.f}; if (k0 + k < nf) sv[k] = *(const f32x4*)(SUM + ((size_t)((cs0 + k0 + k) * 2 + 0) * 1024 + 2 * cp) * 2); }
#pragma unroll
            for (int k = 0; k < 8; ++k) { hf0 = sv[k][0] * hf0 + sv[k][1]; hf1 = sv[k][2] * hf1 + sv[k][3]; } }
        for (int k0 = 0; k0 < nb; k0 += 8) { f32x4 sv[8];
#pragma unroll
            for (int k = 0; k < 8; ++k) { sv[k] = (f32x4){1.f, 0.f, 1.f, 0.f}; if (k0 + k < nb) sv[k] = *(const f32x4*)(SUM + ((size_t)((cs0 + ncs - 1 - k0 - k) * 2 + 1) * 1024 + 2 * cp) * 2); }
#pragma unroll
            for (int k = 0; k < 8; ++k) { hb0 = sv[k][0] * hb0 + sv[k][1]; hb1 = sv[k][2] * hb1 + sv[k][3]; } }
        unsigned* lf = LB + ((size_t)row0) * 1024 + 2 * cp;
        const unsigned* lb = LB + ((size_t)MT + row0) * 1024 + 2 * cp;
#pragma unroll 1
        for (int tb = 0; tb < CH; tb += 16) { u32x2 w[16];
#pragma unroll
            for (int i = 0; i < 16; ++i) w[i] = *(const u32x2*)(lf + (size_t)(tb + i) * 1024);
#pragma unroll
            for (int i = 0; i < 16; ++i) { hf0 = __expf(bflo(w[i].x)) * hf0 + bfhi(w[i].x); hf1 = __expf(bflo(w[i].y)) * hf1 + bfhi(w[i].y);
                *(f32x2*)(lf + (size_t)(tb + i) * 1024) = (f32x2){hf0, hf1}; } }
        if (ctx && c == cs0 + ncs - 1) *(f32x2*)(outh + (size_t)(b * 2 + 0) * 1024 + 2 * cp) = (f32x2){hf0, hf1};
#pragma unroll 1
        for (int tb = CH - 16; tb >= 0; tb -= 16) { u32x2 w[16]; f32x2 hf[16]; unsigned gw[16];
#pragma unroll
            for (int i = 0; i < 16; ++i) { const int t = tb + 15 - i; w[i] = *(const u32x2*)(lb + (size_t)t * 1024); hf[i] = *(const f32x2*)(lf + (size_t)t * 1024); gw[i] = G[(size_t)(row0 + t) * 512 + cp]; }
#pragma unroll
            for (int i = 0; i < 16; ++i) { const int t = tb + 15 - i;
                hb0 = __expf(bflo(w[i].x)) * hb0 + bfhi(w[i].x); hb1 = __expf(bflo(w[i].y)) * hb1 + bfhi(w[i].y);
                YA[(size_t)(row0 + t) * 512 + cp] = cvt_pk_bf16((hf[i].x + hb0) * bflo(gw[i]), (hf[i].y + hb1) * bfhi(gw[i])); } }
        if (ctx && c == cs0) *(f32x2*)(outh + (size_t)(b * 2 + 1) * 1024 + 2 * cp) = (f32x2){hb0, hb1};
    }
}

__global__ void __launch_bounds__(512, 2) mega(Params p) {
    extern __shared__ __attribute__((aligned(16))) unsigned char lds_raw[];
    LAS unsigned char* lds = (LAS unsigned char*)lds_raw;
    cg::grid_group grid = cg::this_grid();
    if (threadIdx.x == 0) { *(volatile LAS unsigned*)(lds + 131072) = 0u; *(volatile LAS unsigned*)(lds + 131076) = 0u; }
    __syncthreads();
    XcdBarrier xbar = xcd_barrier_post((unsigned*)(p.ws + WS_BAR), (volatile LAS unsigned*)(lds + 131072));
    if (p.ph_hi > NPH) grid.sync();
    unsigned char* ws = p.ws;
    const float* mod0 = (const float*)(ws + WS_MOD); const float* mod1 = mod0 + 5 * 6144;
    bf16_t* HA = (bf16_t*)(ws + WS_HA);
    const int G_ = gridDim.x, bx = blockIdx.x;
#ifndef REP_MASK
#define REP_MASK 0u
#endif
#define NREP(k) (1 + (int)((REP_MASK >> (k)) & 1u))
#define PH_BEGIN(k) if (p.ph_lo <= (k) && (k) < p.ph_hi) { for (int rep_ = 0; rep_ < NREP(k); ++rep_) {
#define PH_END(k) if (rep_ + 1 < NREP(k) || (k) + 1 < p.ph_hi) xcd_barrier(xbar); } }
    PH_BEGIN(0) phase_prep(p, lds); PH_END(0)
    PH_BEGIN(1) phase_norm<0>(p, p.in[9], mod0, 0, 1); PH_END(1)
    PH_BEGIN(2) { pg8::Gemm g{HA, (const bf16_t*)(ws + WS_WATTIN), MT, 1792, 1024, 1024, 1024, 30, 0}; pg8::StaticOrder S; S.init(MT, 1792, G_, bx);
                  EpiQKVU E{(bf16_t*)(ws + WS_Q), (bf16_t*)(ws + WS_KB), (bf16_t*)(ws + WS_VTL), (bf16_t*)(ws + WS_VTC), (bf16_t*)(ws + WS_U), p.out + 12582912, p.out + 13107200};
                  pg8::gemm_phase(lds, g, S, E); } PH_END(2)
    PH_BEGIN(3) { int it = bx; for (; it < 192; it += G_) attn_item(p, lds, it); for (; it < 192 + 384; it += G_) conv_item(p, lds, it - 192); } PH_END(3)
    PH_BEGIN(4) { pg8::Gemm g{(const bf16_t*)(ws + WS_MIX), (const bf16_t*)(ws + WS_WATTOUT), MT, 1024, 1024, 1024, 1024, 30, 0}; pg8::StaticOrder S; S.init(MT, 1024, G_, bx);
                  EpiResid<true> E{p.in[0], p.in[1], p.out, mod0 + 2 * 1024}; pg8::gemm_phase(lds, g, S, E);
                  if (bx >= 192) for (int t = bx - 192; t < N_TR1; t += G_ - 192) transpose_group(p, lds, 1, t); } PH_END(4)
    PH_BEGIN(5) phase_norm<1>(p, p.in[10], mod0, 3, 4); PH_END(5)
    PH_BEGIN(6) { pg8::Gemm g{HA, (const bf16_t*)(ws + WS_WFF1), MT, 4096, 1024, 1024, 1024, 30, 0}; pg8::StaticOrder S; S.init(MT, 4096, G_, bx);
                  EpiSqRelu E{(bf16_t*)(ws + WS_F)}; pg8::gemm_phase(lds, g, S, E); } PH_END(6)
    PH_BEGIN(7) { pg8::Gemm g{(const bf16_t*)(ws + WS_F), (const bf16_t*)(ws + WS_WFF2), MT, 1024, 4096, 4096, 4096, 30, 0}; pg8::StaticOrder S; S.init(MT, 1024, G_, bx);
                  EpiResid<false> E{nullptr, nullptr, p.out, mod0 + 5 * 1024}; pg8::gemm_phase(lds, g, S, E);
                  if (bx >= 192) for (int t = bx - 192; t < N_TR2; t += G_ - 192) transpose_group(p, lds, 2, t); } PH_END(7)
    PH_BEGIN(8) phase_norm<1>(p, p.in[9] + 1024, mod1, 0, 1); PH_END(8)
    PH_BEGIN(9) { pg8::Gemm g{HA, (const bf16_t*)(ws + WS_WLRUIN), MT, 2048, 1024, 1024, 1024, 30, 0}; pg8::StaticOrder S; S.init(MT, 2048, G_, bx);
                  EpiLruIn E{(bf16_t*)(ws + WS_G), (bf16_t*)(ws + WS_R)}; pg8::gemm_phase(lds, g, S, E); } PH_END(9)
    PH_BEGIN(10) phase_conv4(p); PH_END(10)
    PH_BEGIN(11) { int k11 = 128; asm volatile("" : "+s"(k11));
                   pg8::Gemm g{HA, (const bf16_t*)(ws + WS_WG), MT, 4096, k11, 1024, 128, 1, 256}; pg8::StaticOrder S; S.init(MT, 4096, G_, bx);
                   EpiGates E{HA, (unsigned*)(ws + WS_LB), p.in[25], p.in[27], p.in[28]}; pg8::gemm_phase(lds, g, S, E); } PH_END(11)
    PH_BEGIN(12) phase_scan_sum(p); PH_END(12)
    PH_BEGIN(13) phase_scan_final(p); PH_END(13)
    PH_BEGIN(14) { pg8::Gemm g{(const bf16_t*)(ws + WS_R), (const bf16_t*)(ws + WS_WLRUOUT), MT, 1024, 1024, 1024, 1024, 30, 0}; pg8::StaticOrder S; S.init(MT, 1024, G_, bx);
                   EpiResid<false> E{nullptr, nullptr, p.out, mod1 + 2 * 1024}; pg8::gemm_phase(lds, g, S, E); } PH_END(14)
    PH_BEGIN(15) phase_norm<1>(p, p.in[10] + 1024, mod1, 3, 4); PH_END(15)
    PH_BEGIN(16) { pg8::Gemm g{HA, (const bf16_t*)(ws + WS_WFF1) + (size_t)4096 * 1024, MT, 4096, 1024, 1024, 1024, 30, 0}; pg8::StaticOrder S; S.init(MT, 4096, G_, bx);
                   EpiSqRelu E{(bf16_t*)(ws + WS_F)}; pg8::gemm_phase(lds, g, S, E); } PH_END(16)
    PH_BEGIN(17) { pg8::Gemm g{(const bf16_t*)(ws + WS_F), (const bf16_t*)(ws + WS_WFF2) + (size_t)1024 * 4096, MT, 1024, 4096, 4096, 4096, 30, 0}; pg8::StaticOrder S; S.init(MT, 1024, G_, bx);
                   EpiResid<false> E{nullptr, nullptr, p.out, mod1 + 5 * 1024}; pg8::gemm_phase(lds, g, S, E); } PH_END(17)
    PH_BEGIN(18) phase_norm<2>(p, p.in[29], mod0, 0, 0); PH_END(18)
}

extern "C" void kernel_launch(void* const* d_in, const int* in_sizes, int n_in, void* d_out, int out_size, void* d_ws, size_t ws_size, hipStream_t stream) {
    static int grid = 0;
    if (grid == 0) {
        if (n_in != 30 || out_size != 13664256 || ws_size < WS_END) { fprintf(stderr, "kernel_launch: unexpected problem (n_in %d out %d ws %zu)\n", n_in, out_size, ws_size); grid = -1; return; }
        int dev = 0, cus = 0, per_cu = 0;
        if (hipGetDevice(&dev) != hipSuccess || hipDeviceGetAttribute(&cus, hipDeviceAttributeMultiprocessorCount, dev) != hipSuccess) { grid = -1; return; }
        if (hipFuncSetAttribute((const void*)mega, hipFuncAttributeMaxDynamicSharedMemorySize, LDS_BYTES) != hipSuccess) { fprintf(stderr, "kernel_launch: hipFuncSetAttribute failed\n"); grid = -1; return; }
        if (hipOccupancyMaxActiveBlocksPerMultiprocessor(&per_cu, (const void*)mega, 512, LDS_BYTES) != hipSuccess || per_cu < 1) { fprintf(stderr, "kernel_launch: occupancy query says %d blocks per CU\n", per_cu); grid = -1; return; }
        grid = cus;
    }
    if (grid < 0) return;
    if (hipMemsetAsync((char*)d_ws + WS_BAR, 0, XCD_BAR_WORDS * 4, stream) != hipSuccess) { fprintf(stderr, "kernel_launch: memset failed\n"); return; }
    Params p{};
    for (int i = 0; i < 30; ++i) p.in[i] = (const float*)d_in[i];
    p.out = (float*)d_out; p.ws = (unsigned char*)d_ws;
#if N_LAUNCH_MODE == 1
    p.ph_lo = 0; p.ph_hi = NPH;
    void* args[] = {&p};
    hipError_t e = hipLaunchCooperativeKernel((const void*)mega, dim3(grid), dim3(512), args, LDS_BYTES, stream);
    if (e != hipSuccess) fprintf(stderr, "cooperative launch failed: %s (grid %d)\n", hipGetErrorString(e), grid);
#else
    for (int ph = 0; ph < NPH; ++ph) { p.ph_lo = ph; p.ph_hi = ph + 1; hipLaunchKernelGGL(mega, dim3(grid), dim3(512), LDS_BYTES, stream, p); }
#endif
}
```
